# Optimizing an MI355X kernel written in HIP

```python
import math
import jax, jax.numpy as jnp
from jax import lax
import numpy as np

D_MODEL = 2048
BATCH = 2
SEQ = 16384
DEPTH = 1

ATTN_HEADS = 8
HEAD_DIM = 128
ATTN_WIDTH = ATTN_HEADS * HEAD_DIM
IDX_HEADS = 8
IDX_DIM = 64
DSA_TOPK = 256
Q_BLOCK = 128
GMLP_GROUPS = 8
GMLP_GROUP_CH = 128
GMLP_WIDTH = GMLP_GROUPS * GMLP_GROUP_CH
CHUNK = 128
N_BRANCH = 2
N_KEYS = 128
N_EXPERTS = N_KEYS * N_KEYS
PEER_HEADS = 8
PEER_QDIM = 256
PEER_TOPK = 16
PEER_TOK_BLOCK = 128
EPS = 1e-6

kernel_name = "hybrid_dsa_gmlp_peer_block"


def rms_norm(x, g):
    xf = x.astype(jnp.float32)
    y = xf * lax.rsqrt(jnp.mean(xf * xf, axis=-1, keepdims=True) + EPS)
    return (y * g.astype(jnp.float32)).astype(x.dtype)


def dsa_attention(q, k, v, q_idx, k_idx, w_idx):
    B, S = q.shape[0], q.shape[1]
    n_sel = min(DSA_TOPK, S // 4)
    nb = S // Q_BLOCK

    def to_blocks(a):
        return jnp.swapaxes(a.reshape((B, nb, Q_BLOCK) + a.shape[2:]), 0, 1)

    q_pos = jnp.arange(S, dtype=jnp.int32).reshape(nb, Q_BLOCK)
    key_pos = jnp.arange(S, dtype=jnp.int32)
    bidx = jnp.arange(B, dtype=jnp.int32)[:, None, None]
    idx_scale = IDX_DIM ** -0.5
    attn_scale = HEAD_DIM ** -0.5

    def block(args):
        qb, qib, wb, qpos = args
        dots = jnp.einsum('bqhd,bsd->bqhs', qib, k_idx).astype(jnp.float32) * idx_scale
        score = jnp.einsum('bqhs,bqh->bqs', jax.nn.relu(dots), wb.astype(jnp.float32))
        causal = key_pos[None, None, :] <= qpos[None, :, None]
        score = jnp.where(causal, score, -jnp.inf)
        _, sel = lax.top_k(score, n_sel)
        valid = sel <= qpos[None, :, None]
        k_sel = k[bidx, sel]
        v_sel = v[bidx, sel]
        logits = jnp.einsum('bqhd,bqkhd->bqhk', qb, k_sel).astype(jnp.float32) * attn_scale
        logits = jnp.where(valid[:, :, None, :], logits, -jnp.inf)
        p = jax.nn.softmax(logits, axis=-1).astype(v.dtype)
        return jnp.einsum('bqhk,bqkhd->bqhd', p, v_sel)

    out = lax.map(block, (to_blocks(q), to_blocks(q_idx), to_blocks(w_idx), q_pos))
    return jnp.swapaxes(out, 0, 1).reshape(B, S, ATTN_WIDTH)


def chunked_spatial_gating(u, v, norm_g, w_s, b_s):
    B, S = u.shape[0], u.shape[1]
    nc = S // CHUNK
    u = jax.nn.gelu(u)
    v = rms_norm(jax.nn.gelu(v), norm_g)
    v = v.reshape(B, nc, CHUNK, GMLP_GROUPS, GMLP_GROUP_CH)
    mask = jnp.tril(jnp.ones((CHUNK, CHUNK), dtype=w_s.dtype))
    z = jnp.einsum('gts,bnsgc->bntgc', w_s * mask[None], v)
    z = z + jnp.swapaxes(b_s, 0, 1)[None, None, :, :, None]
    return u * z.reshape(B, S, GMLP_WIDTH)


def peer(h, w_q, sub_keys, u_emb, v_emb):
    B, S, D = h.shape
    tokens = h.reshape(-1, PEER_TOK_BLOCK, D)
    half = PEER_QDIM // 2

    def block(hb):
        T = hb.shape[0]
        q = (hb @ w_q).reshape(T, PEER_HEADS, 2, half)
        s = jnp.einsum('thpd,hpnd->thpn', q, sub_keys).astype(jnp.float32)
        top_s, top_i = lax.top_k(s, PEER_TOPK)
        cand_s = top_s[:, :, 0, :, None] + top_s[:, :, 1, None, :]
        cand_i = top_i[:, :, 0, :, None] * N_KEYS + top_i[:, :, 1, None, :]
        best_s, best_j = lax.top_k(cand_s.reshape(T, PEER_HEADS, PEER_TOPK * PEER_TOPK), PEER_TOPK)
        expert = jnp.take_along_axis(cand_i.reshape(T, PEER_HEADS, PEER_TOPK * PEER_TOPK), best_j, axis=-1)
        gate = jax.nn.softmax(best_s, axis=-1).astype(hb.dtype)
        u_sel = u_emb[expert]
        v_sel = v_emb[expert]
        act = jax.nn.gelu(jnp.einsum('td,thkd->thk', hb, u_sel))
        return jnp.einsum('thk,thkd->td', gate * act, v_sel)

    return lax.map(block, tokens).reshape(B, S, D)


def setup_inputs(seed: int = 0) -> dict:
    key = jax.random.key(seed)
    ks = jax.random.split(key, 16)
    L = DEPTH
    n_in = 3 * ATTN_WIDTH + IDX_HEADS * IDX_DIM + IDX_DIM + IDX_HEADS + 2 * GMLP_WIDTH + N_BRANCH * D_MODEL

    def nrm(k, shape, scale):
        return jax.random.normal(k, shape, jnp.float32) * scale

    return {
        "x": nrm(ks[0], (BATCH, SEQ, D_MODEL), 1.0),
        "ln_mix_g": 1.0 + nrm(ks[1], (L, D_MODEL), 0.02),
        "w_in": nrm(ks[2], (L, D_MODEL, n_in), D_MODEL ** -0.5),
        "gmlp_norm_g": 1.0 + nrm(ks[3], (L, GMLP_WIDTH), 0.02),
        "w_spatial": nrm(ks[4], (L, GMLP_GROUPS, CHUNK, CHUNK), CHUNK ** -0.5),
        "b_spatial": nrm(ks[5], (L, GMLP_GROUPS, CHUNK), 0.02),
        "w_branch_attn": nrm(ks[6], (L, ATTN_WIDTH, D_MODEL), ATTN_WIDTH ** -0.5),
        "w_branch_gmlp": nrm(ks[7], (L, GMLP_WIDTH, D_MODEL), GMLP_WIDTH ** -0.5),
        "w_out": nrm(ks[8], (L, D_MODEL, D_MODEL), D_MODEL ** -0.5),
        "ln_ffn_g": 1.0 + nrm(ks[9], (L, D_MODEL), 0.02),
        "peer_w_q": nrm(ks[10], (L, D_MODEL, PEER_HEADS * PEER_QDIM), D_MODEL ** -0.5),
        "peer_sub_keys": nrm(ks[11], (L, PEER_HEADS, 2, N_KEYS, PEER_QDIM // 2), (PEER_QDIM // 2) ** -0.5),
        "peer_u": nrm(ks[12], (L, N_EXPERTS, D_MODEL), D_MODEL ** -0.5),
        "peer_v": nrm(ks[13], (L, N_EXPERTS, D_MODEL), (PEER_HEADS * PEER_TOPK) ** -0.5),
        "ln_final_g": 1.0 + nrm(ks[14], (D_MODEL,), 0.02),
    }


def reference(x, ln_mix_g, w_in, gmlp_norm_g, w_spatial, b_spatial, w_branch_attn, w_branch_gmlp,
              w_out, ln_ffn_g, peer_w_q, peer_sub_keys, peer_u, peer_v, ln_final_g):
    B, S, _ = x.shape
    sizes = [ATTN_WIDTH, ATTN_WIDTH, ATTN_WIDTH, IDX_HEADS * IDX_DIM, IDX_DIM, IDX_HEADS,
             GMLP_WIDTH, GMLP_WIDTH, D_MODEL, D_MODEL]
    split_at = [int(c) for c in np.cumsum(sizes)[:-1]]
    for l in range(DEPTH):
        h = rms_norm(x, ln_mix_g[l])
        proj = h @ w_in[l]
        q, k, v, qi, ki, wi, gu, gv, ga, gb = jnp.split(proj, split_at, axis=-1)
        q = q.reshape(B, S, ATTN_HEADS, HEAD_DIM)
        k = k.reshape(B, S, ATTN_HEADS, HEAD_DIM)
        v = v.reshape(B, S, ATTN_HEADS, HEAD_DIM)
        qi = qi.reshape(B, S, IDX_HEADS, IDX_DIM)
        wi = wi * (IDX_HEADS ** -0.5)
        y_a = dsa_attention(q, k, v, qi, ki, wi)
        y_b = chunked_spatial_gating(gu, gv, gmlp_norm_g[l], w_spatial[l], b_spatial[l])
        mixed = jax.nn.sigmoid(ga) * (y_a @ w_branch_attn[l]) + jax.nn.sigmoid(gb) * (y_b @ w_branch_gmlp[l])
        x = x + mixed @ w_out[l]
        x = x + peer(rms_norm(x, ln_ffn_g[l]), peer_w_q[l], peer_sub_keys[l], peer_u[l], peer_v[l])
    return rms_norm(x, ln_final_g)
```

```cpp
#include <hip/hip_runtime.h>
#include <cstdio>
#include <cstdint>
#define MK_N_LAUNCHES 1
#define GAS __attribute__((address_space(1)))
#define LAS __attribute__((address_space(3)))
namespace pg8 {
#define PG8_LAS __attribute__((address_space(3)))
typedef unsigned short bf16_t;
typedef short bf16x8 __attribute__((ext_vector_type(8)));
typedef float f32x4 __attribute__((ext_vector_type(4)));
typedef unsigned u32x4 __attribute__((ext_vector_type(4)));
constexpr int BM = 256, BK = 64, HALF = 128, HTB = HALF * BK * 2  , STAGE_BYTES = 8 * HTB, NXCD = 8, WGM = 8;

__host__ __device__ __forceinline__ int lds_byte(int r, int c) { const int st = (r >> 4) * 2 + (c >> 5), rr = r & 15, cc = c & 31, ob = rr * 64 + cc * 2; return st * 1024 + (ob ^ (((ob >> 9) & 1) << 5)); }
__host__ __device__ __forceinline__ void stage_rc(int b, int& R, int& C) { const int st = b / 1024, sb = b % 1024, swz = sb ^ (((sb >> 9) & 1) << 5); R = (st >> 1) * 16 + swz / 64; C = (st & 1) * 32 + (swz % 64) / 2; }
__host__ __device__ __forceinline__ int perm32(int rho) { const int n = rho >> 4, i = rho & 15; return 8 * (i >> 2) + 4 * n + (i & 3); }

struct Unit { int pm, pn; };
struct Gemm { const bf16_t* A; const bf16_t* Bt; int M, N, K; };

struct StaticOrder {
    int nM, nN, nwg, G, c;
    __host__ __device__ void init(int M, int N, int G_, int c_) { nM = M / BM; nN = N / BM; nwg = nM * nN; G = G_; c = c_; }
    __host__ __device__ bool next(int i, Unit& u) const {
        const long L = (long)i * G + c; if (L >= nwg) return false;
        int wgid = (int)L; { const int q = nwg / NXCD, r = nwg % NXCD, xcd = wgid % NXCD, off = wgid / NXCD; wgid = (xcd < r ? xcd * (q + 1) : r * (q + 1) + (xcd - r) * q) + off; }
        const int nig = WGM * nN, gid = wgid / nig, fm = gid * WGM, gsz = (nM - fm) < WGM ? (nM - fm) : WGM;
        u.pm = fm + ((wgid % nig) % gsz); u.pn = (wgid % nig) / gsz; return true;
    }
    __device__ __forceinline__ void a_ready(const Unit&) const {}
    __device__ __forceinline__ void done(const Unit&) const {}
};

__device__ __forceinline__ unsigned cvt_pk_bf16(float lo, float hi) { unsigned r; asm volatile("v_cvt_pk_bf16_f32 %0, %1, %2" : "=v"(r) : "v"(lo), "v"(hi)); return r; }
typedef float f32x2 __attribute__((ext_vector_type(2)));
template <class Epi, class Sched, bool ALIGN_EPI = false, bool SP2 = false, bool I8 = false>
__device__ __forceinline__ void gemm_phase(PG8_LAS unsigned char* lds, const Gemm g, const Sched& S, const Epi& E) {
    typedef int i32x4_t __attribute__((ext_vector_type(4)));
    const int tid = threadIdx.x, wid = __builtin_amdgcn_readfirstlane(tid >> 6), lane = tid & 63, wr = wid >> 2, wc = wid & 3, fr = lane & 15, fq = lane >> 4;
    const int K = g.K, nt = K / BK;
    unsigned voffA[2], voffB[2];
#pragma unroll
    for (int i = 0; i < 2; ++i) { int R, C; stage_rc(tid * 16 + i * 8192, R, C); const int Rb = Epi::PERM ? ((R & ~31) + perm32(R & 31)) : R;
        voffA[i] = (unsigned)(R * K + C) * 2u; voffB[i] = (unsigned)(Rb * K + C) * 2u; }
    const size_t kstep = (size_t)(BK * 2);
    const size_t hstep = (size_t)HALF * K * 2;
    const size_t tstep = 2 * hstep;
    const unsigned ldsw = (unsigned)wid * 1024u;
    const int aoff = lds_byte(wr * 64 + fr, fq * 8), boff = lds_byte(wc * 32 + fr, fq * 8);
#define PG8_SA(b, h) (((b) * 2 + (h)) * HTB)
#define PG8_SB(b, h) ((4 + (b) * 2 + (h)) * HTB)
#define PG8_STAGE(bufoff, gbase, voff) do { _Pragma("unroll") for (int _i = 0; _i < 2; ++_i) \
        __builtin_amdgcn_global_load_lds((const unsigned*)((const char*)(gbase) + (voff)[_i]), (PG8_LAS unsigned*)(lds + (bufoff) + ldsw + _i * 8192), 16, 0, 0); } while (0)
#define PG8_LDA(dst, b, h) do { _Pragma("unroll") for (int m = 0; m < 4; ++m) _Pragma("unroll") for (int k = 0; k < 2; ++k) dst[m][k] = *(const PG8_LAS bf16x8*)(lds + PG8_SA(b, h) + aoff + m * 2048 + k * 1024); } while (0)
#define PG8_LDB(dst, b, h) do { _Pragma("unroll") for (int n = 0; n < 2; ++n) _Pragma("unroll") for (int k = 0; k < 2; ++k) dst[n][k] = *(const PG8_LAS bf16x8*)(lds + PG8_SB(b, h) + boff + n * 2048 + k * 1024); } while (0)
#define PG8_MMA(ai, bj, At, Bt) do { __builtin_amdgcn_s_setprio(1); _Pragma("unroll") for (int m = 0; m < 4; ++m) _Pragma("unroll") for (int n = 0; n < 2; ++n) _Pragma("unroll") for (int k = 0; k < 2; ++k) \
        { if constexpr (I8) acc[ai][bj][m][n] = __builtin_bit_cast(f32x4, __builtin_amdgcn_mfma_i32_16x16x64_i8(__builtin_bit_cast(i32x4_t, Bt[n][k]), __builtin_bit_cast(i32x4_t, At[m][k]), __builtin_bit_cast(i32x4_t, acc[ai][bj][m][n]), 0, 0, 0)); \
          else acc[ai][bj][m][n] = __builtin_amdgcn_mfma_f32_16x16x32_bf16(Bt[n][k], At[m][k], acc[ai][bj][m][n], 0, 0, 0); } __builtin_amdgcn_s_setprio(0); } while (0)
#define PG8_WAIT_V(n) asm volatile("s_waitcnt vmcnt(" #n ")" ::: "memory")
#define PG8_WAIT_L(n) asm volatile("s_waitcnt lgkmcnt(" #n ")" ::: "memory")
#define PG8_BAR __builtin_amdgcn_s_barrier()
#define PG8_SCHED __builtin_amdgcn_sched_barrier(0)
    Unit cur, nxt; int ui = 0;
    if (!S.next(0, cur)) return;
    f32x4 acc[2][2][4][2];
#pragma unroll
    for (int a = 0; a < 2; ++a)
#pragma unroll
        for (int b = 0; b < 2; ++b)
#pragma unroll
            for (int m = 0; m < 4; ++m)
#pragma unroll
                for (int n = 0; n < 2; ++n) acc[a][b][m][n] = (f32x4){0.f, 0.f, 0.f, 0.f};
    bf16x8 At[4][2], B0[2][2], B1[2][2];
    const char* cA = (const char*)g.A + (size_t)cur.pm * tstep; const char* cB = (const char*)g.Bt + (size_t)cur.pn * tstep;
    S.a_ready(cur);
    if constexpr (SP2) {
        PG8_STAGE(PG8_SB(0, 0), cB, voffB); PG8_STAGE(PG8_SB(0, 1), cB + hstep, voffB); PG8_STAGE(PG8_SA(0, 0), cA, voffA); PG8_STAGE(PG8_SA(0, 1), cA + hstep, voffA);
        if (wr == 1) PG8_BAR;
        PG8_WAIT_V(2); PG8_BAR;
        PG8_STAGE(PG8_SB(1, 0), cB + kstep, voffB); PG8_STAGE(PG8_SA(1, 0), cA + kstep, voffA); PG8_STAGE(PG8_SB(1, 1), cB + hstep + kstep, voffB);
        PG8_WAIT_V(6); PG8_BAR;
    } else {
        PG8_STAGE(PG8_SB(0, 0), cB, voffB); PG8_STAGE(PG8_SA(0, 0), cA, voffA); PG8_STAGE(PG8_SB(0, 1), cB + hstep, voffB); PG8_STAGE(PG8_SA(0, 1), cA + hstep, voffA);
        if (wr == 1) PG8_BAR;
        PG8_WAIT_V(4); PG8_BAR;
        PG8_STAGE(PG8_SB(1, 0), cB + kstep, voffB); PG8_STAGE(PG8_SA(1, 0), cA + kstep, voffA); PG8_STAGE(PG8_SB(1, 1), cB + hstep + kstep, voffB);
        PG8_WAIT_V(6); PG8_BAR;
    }
    for (;;) {
        const bool has_next = S.next(ui + 1, nxt);
        const char* nA = has_next ? (const char*)g.A + (size_t)nxt.pm * tstep : cA; const char* nB = has_next ? (const char*)g.Bt + (size_t)nxt.pn * tstep : cB;
        for (int t = 0; t < nt; t += 2) {
            const bool last = (t == nt - 2);
            const char* a1 = cA + (size_t)(t + 1) * kstep;
            const char* a2 = last ? nA : cA + (size_t)(t + 2) * kstep; const char* b2 = last ? nB : cB + (size_t)(t + 2) * kstep;
            const char* a3 = a2 + kstep; const char* b3 = b2 + kstep;
            if (last && has_next) S.a_ready(nxt);
            if constexpr (SP2) {
            PG8_LDB(B0, 0, 0); PG8_LDB(B1, 0, 1); PG8_SCHED; PG8_LDA(At, 0, 0); PG8_STAGE(PG8_SA(1, 1), a1 + hstep, voffA);
            PG8_WAIT_V(8); PG8_WAIT_L(0); PG8_BAR; PG8_MMA(0, 0, At, B0); PG8_MMA(0, 1, At, B1); PG8_BAR; PG8_SCHED;
            PG8_LDA(At, 0, 1); PG8_STAGE(PG8_SB(0, 0), b2, voffB); PG8_STAGE(PG8_SB(0, 1), b2 + hstep, voffB); PG8_STAGE(PG8_SA(0, 0), a2, voffA);
            PG8_WAIT_V(8); PG8_WAIT_L(0); PG8_BAR; PG8_MMA(1, 0, At, B0); PG8_MMA(1, 1, At, B1); PG8_BAR; PG8_SCHED;
            PG8_LDB(B0, 1, 0); PG8_LDB(B1, 1, 1); PG8_SCHED; PG8_LDA(At, 1, 0); PG8_STAGE(PG8_SA(0, 1), a2 + hstep, voffA);
            PG8_WAIT_V(8); PG8_WAIT_L(0); PG8_BAR; PG8_MMA(0, 0, At, B0); PG8_MMA(0, 1, At, B1); PG8_BAR; PG8_SCHED;
            PG8_LDA(At, 1, 1); PG8_STAGE(PG8_SB(1, 0), b3, voffB); PG8_STAGE(PG8_SB(1, 1), b3 + hstep, voffB); PG8_STAGE(PG8_SA(1, 0), a3, voffA);
            PG8_WAIT_V(8); PG8_WAIT_L(0); PG8_BAR; PG8_MMA(1, 0, At, B0); PG8_MMA(1, 1, At, B1); PG8_BAR; PG8_SCHED;
            } else {
            PG8_LDB(B0, 0, 0); PG8_SCHED; PG8_LDA(At, 0, 0); PG8_STAGE(PG8_SA(1, 1), a1 + hstep, voffA);
            PG8_WAIT_L(8); PG8_BAR; PG8_WAIT_L(0); PG8_MMA(0, 0, At, B0); PG8_BAR; PG8_SCHED;
            PG8_LDB(B1, 0, 1); PG8_STAGE(PG8_SB(0, 0), b2, voffB);
            PG8_BAR; PG8_WAIT_L(0); PG8_MMA(0, 1, At, B1); PG8_BAR;
            PG8_LDA(At, 0, 1); PG8_STAGE(PG8_SA(0, 0), a2, voffA);
            PG8_BAR; PG8_WAIT_L(0); PG8_MMA(1, 0, At, B0); PG8_BAR; PG8_SCHED;
            PG8_STAGE(PG8_SB(0, 1), b2 + hstep, voffB);
            PG8_WAIT_V(6); PG8_BAR; PG8_MMA(1, 1, At, B1); PG8_BAR;
            PG8_LDB(B0, 1, 0); PG8_SCHED; PG8_LDA(At, 1, 0); PG8_STAGE(PG8_SA(0, 1), a2 + hstep, voffA);
            PG8_WAIT_L(8); PG8_BAR; PG8_WAIT_L(0); PG8_MMA(0, 0, At, B0); PG8_BAR; PG8_SCHED;
            PG8_LDB(B1, 1, 1); PG8_STAGE(PG8_SB(1, 0), b3, voffB);
            PG8_BAR; PG8_WAIT_L(0); PG8_MMA(0, 1, At, B1); PG8_BAR;
            PG8_LDA(At, 1, 1); PG8_STAGE(PG8_SA(1, 0), a3, voffA);
            PG8_BAR; PG8_WAIT_L(0); PG8_MMA(1, 0, At, B0); PG8_BAR; PG8_SCHED;
            PG8_STAGE(PG8_SB(1, 1), b3 + hstep, voffB);
            PG8_WAIT_V(6); PG8_BAR; PG8_MMA(1, 1, At, B1); PG8_BAR;
            }
        }
        if constexpr (ALIGN_EPI) { if (wr == 0) PG8_BAR; }
        if constexpr (!Epi::AFTER_DRAIN) { E(acc, cur, wr, wc, fr, fq); S.done(cur); }
        if (!has_next) break;
#pragma unroll
        for (int a = 0; a < 2; ++a)
#pragma unroll
            for (int b = 0; b < 2; ++b)
#pragma unroll
                for (int m = 0; m < 4; ++m)
#pragma unroll
                    for (int n = 0; n < 2; ++n) acc[a][b][m][n] = (f32x4){0.f, 0.f, 0.f, 0.f};
        cur = nxt; cA = nA; cB = nB; ++ui;
        if constexpr (ALIGN_EPI) { if (wr == 1) PG8_BAR; }
    }
    PG8_WAIT_V(0);
    if constexpr (!ALIGN_EPI) { if (wr == 0) PG8_BAR; }
    PG8_BAR;
    if constexpr (Epi::AFTER_DRAIN) { E.fused(acc, cur, wr, wc, fr, fq, lds, wid, lane); S.done(cur); }
#undef PG8_SA
#undef PG8_SB
#undef PG8_STAGE
#undef PG8_LDA
#undef PG8_LDB
#undef PG8_MMA
#undef PG8_WAIT_V
#undef PG8_WAIT_L
#undef PG8_BAR
#undef PG8_SCHED
}
}
#define XB_TMO      128
#define XB_XCNT(j)  (256  + 64 * (j))
#define XB_XSUB(j)  (1280 + 64 * (j))
#define XB_XGEN(j)  (2304 + 64 * (j))
#define XB_TOP      3328
#define XB_TOPGEN   3392
#define XCD_BAR_WORDS 3456
#define XB_SPIN_CAP (1u << 18)

__device__ __forceinline__ unsigned xb_ld(unsigned* p)              { return __hip_atomic_load(p, __ATOMIC_RELAXED, __HIP_MEMORY_SCOPE_AGENT); }
__device__ __forceinline__ unsigned xb_add(unsigned* p, unsigned v) { return __hip_atomic_fetch_add(p, v, __ATOMIC_RELAXED, __HIP_MEMORY_SCOPE_AGENT); }
__device__ __forceinline__ unsigned xb_xcc_id() { return (unsigned)__builtin_amdgcn_s_getreg((3 << 11) | 20) & 0xFu; }
#define XB_SPIN(cond, bar) do { unsigned _sp = 0; while (cond) { __builtin_amdgcn_s_sleep(1); \
    if ((++_sp & 255u) == 0u) { if (xb_ld(&(bar)[XB_TMO])) break; if (_sp > XB_SPIN_CAP) { atomicAdd(&(bar)[XB_TMO], 1u); break; } } } } while (0)

struct XcdBarrier {
    unsigned* bar; unsigned x;
    volatile LAS unsigned* st;
};

__device__ __forceinline__ XcdBarrier xcd_barrier_post(unsigned* bar, volatile LAS unsigned* st) {
    XcdBarrier b; b.bar = bar; b.x = xb_xcc_id(); b.st = st;
    if (threadIdx.x == 0) (void)xb_add(&bar[XB_XCNT(b.x)], 1u);
    return b;
}
__device__ __forceinline__ void xcd_barrier_complete(unsigned* bar, unsigned x, unsigned& nloc, unsigned& nx) {
    const unsigned G = gridDim.x * gridDim.y * gridDim.z;
    unsigned sum, cnt, mine, sp = 0u;
    for (;;) {
        sum = 0u; cnt = 0u; mine = 0u;
#pragma unroll
        for (unsigned j = 0; j < 16; ++j) { const unsigned c = xb_ld(&bar[XB_XCNT(j)]); sum += c; cnt += (c > 0u) ? 1u : 0u; mine = (j == x) ? c : mine; }
        if (sum == G) break;
        __builtin_amdgcn_s_sleep(1);
        if ((++sp & 255u) == 0u) { if (xb_ld(&bar[XB_TMO])) break; if (sp > XB_SPIN_CAP) { atomicAdd(&bar[XB_TMO], 1u); break; } }
    }
    nloc = mine > 0u ? mine : 1u; nx = cnt > 0u ? cnt : 1u;
}

__device__ __forceinline__ void xcd_barrier(const XcdBarrier& b) {
    asm volatile("s_waitcnt vmcnt(0)" ::: "memory");
    __syncthreads();
    if (threadIdx.x == 0) {
        unsigned* bar = b.bar;
        __builtin_amdgcn_s_waitcnt(0);
        unsigned nloc = b.st[0], nx = b.st[1];
        if (nloc == 0u) { xcd_barrier_complete(bar, b.x, nloc, nx); b.st[0] = nloc; b.st[1] = nx; }
        const unsigned old = xb_add(&bar[XB_XSUB(b.x)], 1u);
        const unsigned gen = old / nloc;
        if (old + 1u == (gen + 1u) * nloc) {
            __builtin_amdgcn_fence(__ATOMIC_RELEASE, "agent");
            asm volatile("s_waitcnt vmcnt(0)" ::: "memory");
            const unsigned og = xb_add(&bar[XB_TOP], 1u);
            const unsigned tg = og / nx;
            if (og + 1u == (tg + 1u) * nx) xb_add(&bar[XB_TOPGEN], 1u);
            else XB_SPIN(xb_ld(&bar[XB_TOPGEN]) == tg, bar);
            __builtin_amdgcn_fence(__ATOMIC_ACQUIRE, "agent");
            xb_add(&bar[XB_XGEN(b.x)], 1u);
            asm volatile("s_waitcnt vmcnt(0)" ::: "memory");
        } else {
            XB_SPIN(xb_ld(&bar[XB_XGEN(b.x)]) == gen, bar);
            __builtin_amdgcn_fence(__ATOMIC_ACQUIRE, "agent");
            asm volatile("s_waitcnt vmcnt(0)" ::: "memory");
        }
    }
    __syncthreads();
}

namespace att {
constexpr int D = 128, ODM = 1024;
constexpr float SCALE = 0.08838834764831845f;
constexpr int NW = 8, QBLK = 32, KVBLK = 64, QB = NW * QBLK;
constexpr int SHM_V = KVBLK * D * 2, SHM_K = KVBLK * D * 2;
constexpr int LDS_BYTES = 2 * SHM_V + 2 * SHM_K + NW * 64 * 4;
constexpr float THR = 8.f;
using bf16 = unsigned short;
typedef short bf16x8 __attribute__((ext_vector_type(8)));
typedef short s16x4 __attribute__((ext_vector_type(4)));
typedef float f32x16 __attribute__((ext_vector_type(16)));
typedef float f32x4 __attribute__((ext_vector_type(4)));
typedef unsigned u32x4 __attribute__((ext_vector_type(4)));

#define KSWZ(row, colB) ((row) * 256 + ((colB) ^ (((row) & 7) << 4)))
#define SBAR() __builtin_amdgcn_sched_barrier(0)
__device__ __forceinline__ int v_st(int k, int c) { const int kk = (k & ~0xC) | ((k & 4) << 1) | ((k & 8) >> 1); return ((kk >> 3) * 4 + (c >> 5)) * 512 + ((kk & 7) * 32 + (c & 31)) * 2; }
__device__ __forceinline__ int v_rd_base(int lane) { return ((lane & 3) << 3) | (((lane >> 2) & 3) << 6) | (((lane >> 4) & 1) << 5) | (((lane >> 5) & 1) << 8); }
constexpr int v_rd_off(int d0, int ks, int half) { return d0 * 512 + ks * 4096 + half * 2048; }
__device__ __forceinline__ int crow(int r, int hi) { return (r & 3) + 8 * (r >> 2) + 4 * hi; }
__device__ __forceinline__ unsigned cvtpk(float lo, float hi) { unsigned r; asm volatile("v_cvt_pk_bf16_f32 %0, %1, %2" : "=v"(r) : "v"(lo), "v"(hi)); return r; }
__device__ __forceinline__ bf16x8 load8(const bf16* p) { return *reinterpret_cast<const bf16x8*>(p); }
__device__ __forceinline__ void mask_tile(f32x16& p0, f32x16& p1, int dq, unsigned W) {
    const float NEG = -__builtin_inff();
#pragma unroll
    for (int r = 0; r < 16; ++r) {
        const int c = (r & 3) + 8 * (r >> 2);
        if ((unsigned)(dq - c) >= W) p0[r] = NEG;
        if ((unsigned)(dq - c - 32) >= W) p1[r] = NEG;
    }
}
__device__ __forceinline__ float bitand_f(float v, int m) { return __uint_as_float(__float_as_uint(v) & (unsigned)m); }
__device__ __forceinline__ void partialSM(f32x16& p0, f32x16& p1, float& m_reg, float& mn, float& alpha, unsigned mw) {
    float pmax = p0[0]; for (int r = 1; r < 16; ++r) pmax = fmaxf(pmax, p0[r]); for (int r = 0; r < 16; ++r) pmax = fmaxf(pmax, p1[r]);
    { auto rr = __builtin_amdgcn_permlane32_swap(__float_as_uint(pmax), __float_as_uint(pmax), false, false);
      pmax = fmaxf(__uint_as_float(rr[0]), __uint_as_float(rr[1])); }
    constexpr float C2 = 1.4426950408889634f * SCALE;
    if (__builtin_expect(__all((pmax - m_reg) * SCALE <= THR), 1)) { mn = m_reg; alpha = 1.f; }
    else { mn = fmaxf(m_reg, pmax); alpha = __builtin_amdgcn_exp2f((m_reg - mn) * C2); m_reg = mn; }
    const float mnL = -mn * C2;
    for (int r = 0; r < 16; ++r) p0[r] = fmaf(p0[r], C2, mnL); for (int r = 0; r < 16; ++r) p1[r] = fmaf(p1[r], C2, mnL);
    unsigned ms = mw << 16;
#pragma unroll
    for (int r = 15; r >= 0; --r) { float e = __builtin_amdgcn_exp2f(p0[r]); asm volatile("v_add_co_u32 %0, vcc, %0, %0\n\tv_cndmask_b32 %1, 0, %1, vcc" : "+v"(ms), "+v"(e) : : "vcc"); p0[r] = e; }
}
__device__ __forceinline__ void finishSM(f32x16& p0, f32x16& p1, float alpha, float& l_reg, bf16x8& pa0, bf16x8& pa1, bf16x8& pa2, bf16x8& pa3, unsigned mw) {
    unsigned ms = mw;
#pragma unroll
    for (int r = 15; r >= 0; --r) { float e = __builtin_amdgcn_exp2f(p1[r]); asm volatile("v_add_co_u32 %0, vcc, %0, %0\n\tv_cndmask_b32 %1, 0, %1, vcc" : "+v"(ms), "+v"(e) : : "vcc"); p1[r] = e; }
    float ps = 0; for (int r = 0; r < 16; ++r) ps += p0[r]; for (int r = 0; r < 16; ++r) ps += p1[r];
    { auto rr = __builtin_amdgcn_permlane32_swap(__float_as_uint(ps), __float_as_uint(ps), false, false);
      ps = __uint_as_float(rr[0]) + __uint_as_float(rr[1]); }
    l_reg = l_reg * alpha + ps;
#define PK4(P, B_, OUT) do { unsigned a0 = cvtpk(P[B_+0], P[B_+1]), a1 = cvtpk(P[B_+2], P[B_+3]);                          \
        unsigned b0 = cvtpk(P[B_+4], P[B_+5]), b1 = cvtpk(P[B_+6], P[B_+7]);                                             \
        auto r0 = __builtin_amdgcn_permlane32_swap(a0, b0, false, false); auto r1 = __builtin_amdgcn_permlane32_swap(a1, b1, false, false); \
        u32x4 w = {r0[0], r1[0], r0[1], r1[1]}; OUT = *reinterpret_cast<bf16x8*>(&w); } while (0)
    PK4(p0, 0, pa0); PK4(p0, 8, pa1); PK4(p1, 0, pa2); PK4(p1, 8, pa3);
#undef PK4
}
template <int KB>
__device__ __forceinline__ void qkt(f32x16& p0, f32x16& p1, const char* K_lds, int r32, int hi, const bf16x8* qr) {
    p0 = f32x16{}; p1 = f32x16{};
    const char* kb[4];
#pragma unroll
    for (int dd = 0; dd < 4; ++dd) kb[dd] = K_lds + KB * SHM_K + KSWZ(r32, (dd * 16 + hi * 8) * 2);
#pragma unroll
    for (int d0 = 0; d0 < 8; ++d0) { const char* a = kb[d0 & 3] + (d0 >> 2) * 128;
        bf16x8 b0 = *reinterpret_cast<const bf16x8*>(a);
        bf16x8 b1 = *reinterpret_cast<const bf16x8*>(a + 32 * 256);
        p0 = __builtin_amdgcn_mfma_f32_32x32x16_bf16(b0, qr[d0], p0, 0, 0, 0);
        p1 = __builtin_amdgcn_mfma_f32_32x32x16_bf16(b1, qr[d0], p1, 0, 0, 0); }
}
template <int VB>
__device__ __forceinline__ void pv_tile(f32x16* o, int vb0, bf16x8 pa0, bf16x8 pa1, bf16x8 pa2, bf16x8 pa3) {
#define TRRD(dst, off) asm volatile("ds_read_b64_tr_b16 %0, %1 offset:%2" : "=&v"(dst) : "v"(vb0), "i"(off) : "memory")
#define PV_D0(d0) do { s16x4 l0, l1, l2, l3, h0, h1, h2, h3; constexpr int b_ = VB * SHM_V + v_rd_off(d0, 0, 0); \
        TRRD(l0, b_); TRRD(h0, b_ + 2048); TRRD(l1, b_ + 4096); TRRD(h1, b_ + 6144); TRRD(l2, b_ + 8192); TRRD(h2, b_ + 10240); TRRD(l3, b_ + 12288); TRRD(h3, b_ + 14336); \
        asm volatile("s_waitcnt lgkmcnt(0)" ::: "memory"); SBAR();   \
        o[d0] = __builtin_amdgcn_mfma_f32_32x32x16_bf16(pa0, (bf16x8){l0[0], l0[1], l0[2], l0[3], h0[0], h0[1], h0[2], h0[3]}, o[d0], 0, 0, 0);   \
        o[d0] = __builtin_amdgcn_mfma_f32_32x32x16_bf16(pa1, (bf16x8){l1[0], l1[1], l1[2], l1[3], h1[0], h1[1], h1[2], h1[3]}, o[d0], 0, 0, 0);   \
        o[d0] = __builtin_amdgcn_mfma_f32_32x32x16_bf16(pa2, (bf16x8){l2[0], l2[1], l2[2], l2[3], h2[0], h2[1], h2[2], h2[3]}, o[d0], 0, 0, 0);   \
        o[d0] = __builtin_amdgcn_mfma_f32_32x32x16_bf16(pa3, (bf16x8){l3[0], l3[1], l3[2], l3[3], h3[0], h3[1], h3[2], h3[3]}, o[d0], 0, 0, 0); } while (0)
    PV_D0(0); PV_D0(1); PV_D0(2); PV_D0(3);
#undef PV_D0
#undef TRRD
}

struct BlockRef { unsigned qo, ko, vo, oo, mo; int P0; };
struct Bufs { __amdgpu_buffer_rsrc_t q, k, v, o, m; };
__device__ __forceinline__ bf16x8 bld8(__amdgpu_buffer_rsrc_t r, int voff, int soff) { return __builtin_bit_cast(bf16x8, __builtin_amdgcn_raw_buffer_load_b128(r, voff, soff, 0)); }
struct Seam { bf16x8 qr[8]; bf16x8 st_v0, st_v1, st_k0, st_k1; };
#define VMW() asm volatile("s_waitcnt vmcnt(0)" ::: "memory")
#define VMWN(n) asm volatile("s_waitcnt vmcnt(%0)" :: "i"(n) : "memory")
#define SLOAD_H(R, k0) do { S.st_v0 = bld8(B.v, vkv, (R).vo + (k0) * 256); S.st_v1 = bld8(B.v, vkv, (R).vo + ((k0) + 32) * 256);              \
                         S.st_k0 = bld8(B.k, vkv, (R).ko + (k0) * 256); S.st_k1 = bld8(B.k, vkv, (R).ko + ((k0) + 32) * 256); } while (0)
#define SWRITE_HK(bf) do { *(bf16x8*)(K_lds + (bf) * SHM_K + kws) = S.st_k0; *(bf16x8*)(K_lds + (bf) * SHM_K + kws + 32 * 256) = S.st_k1; } while (0)
#define SWRITE_HV(bf) do { *(bf16x8*)(V_lds + (bf) * SHM_V + vst0) = S.st_v0; *(bf16x8*)(V_lds + (bf) * SHM_V + vst1) = S.st_v1; } while (0)
#define SWRITE_H(bf) do { SWRITE_HV(bf); SWRITE_HK(bf); } while (0)
__device__ __forceinline__ void attn_prime(const Bufs& B, const BlockRef& cur, char* lds, Seam& S) {
    const int tid = threadIdx.x, wid = __builtin_amdgcn_readfirstlane(tid >> 6), lane = tid & 63, r32 = lane & 31, hi = lane >> 5;
    const int sr = tid >> 4, sc = (tid & 15) * 8, kws = KSWZ(sr, sc * 2); char* K_lds = lds + 2 * SHM_V;
    const int vkv = sr * 256 + sc * 2, vq = ((wid * QBLK + r32) * D + hi * 8) * 2;
    for (int d0 = 0; d0 < 8; ++d0) S.qr[d0] = bld8(B.q, vq + d0 * 32, cur.qo);
    SLOAD_H(cur, 0); VMW(); SWRITE_HK(0);
    __syncthreads();
}
__device__ __forceinline__ void attn_block(const Bufs& B, const BlockRef& cur, const BlockRef& nxt, int S_len, char* lds, Seam& S) {
    const int tid = threadIdx.x, wid = __builtin_amdgcn_readfirstlane(tid >> 6), lane = tid & 63, r32 = lane & 31, hi = lane >> 5;
    const int W = 1 << 30;
    const int j_lo = 0;
    const int j_hi = (cur.P0 + QB - 1) / KVBLK + 1;
    const int NT = j_hi - j_lo;
    const int kbn = 0;
    const int qlo = cur.P0 + wid * QBLK, qm = qlo + r32 - 4 * hi;
    char* V_lds = lds; char* K_lds = lds + 2 * SHM_V;
    float* ws = (float*)(lds + 2 * SHM_V + 2 * SHM_K) + wid * 64; float* li_l = ws, * al_l = ws + 32;
    float m_reg = -1e30f, l_reg = 0; f32x16 o[4] = {};
    const int sr = tid >> 4, sc = (tid & 15) * 8, vst0 = v_st(sr, sc), vst1 = v_st(32 + sr, sc), kws = KSWZ(sr, sc * 2);
    const int vb0 = (int)(uintptr_t)V_lds + v_rd_base(lane);
    const int vkv = sr * 256 + sc * 2, vq = ((wid * QBLK + r32) * D + hi * 8) * 2;
    const int vm = ((qlo + r32) * 2 + hi) * 4; const int mws = S_len * 8;
#define MLOAD(t) __builtin_amdgcn_raw_buffer_load_b32(B.m, vm, cur.mo + (t) * mws, 0)
#define RESC(a) do { if (__any((a) < 1.f)) { if (hi == 0) al_l[r32] = (a); asm volatile("s_waitcnt lgkmcnt(0)" ::: "memory");              \
                     for (int d_ = 0; d_ < 4; ++d_) for (int r = 0; r < 16; ++r) o[d_][r] *= al_l[crow(r, hi)]; } } while (0)
#define KBASE(t) ((j_lo + (t)) * KVBLK)
#define MASKT(P0_, P1_, t) do { const int kb_ = KBASE(t); if (kb_ + KVBLK - 1 > qlo) mask_tile(P0_, P1_, qm - kb_, (unsigned)W); } while (0)
    constexpr int NQL = 8;
#define SEAM_K0() do { VMWN(NQL); SWRITE_HK(0); SBAR(); } while (0)
    f32x16 pA0, pA1, pB0, pB1; float mnA, mnB, alA, alB; bf16x8 pa0, pa1, pa2, pa3; unsigned mwA, mwB;
    SWRITE_HV(0); SBAR();
    mwA = MLOAD(0);
    if (NT > 1) { SLOAD_H(cur, KBASE(1)); }
    SBAR(); qkt<0>(pA0, pA1, K_lds, r32, hi, S.qr);
    MASKT(pA0, pA1, 0); partialSM(pA0, pA1, m_reg, mnA, alA, mwA);
    if (NT > 1) { VMW(); SWRITE_H(1); }
    __syncthreads();
#define HALF_STEP(PX0, PX1, mnX, alX, mwX, PY0, PY1, alY, mwY, t, KB, VB, SB) do {                                            \
        mwX = MLOAD(t);                                                                                         \
        SBAR(); qkt<KB>(PX0, PX1, K_lds, r32, hi, S.qr);                                                                      \
        finishSM(PY0, PY1, alY, l_reg, pa0, pa1, pa2, pa3, mwY); SBAR();                                                      \
        if ((t) + 1 < NT) { SLOAD_H(cur, KBASE((t) + 1)); SBAR(); }                                                        \
        pv_tile<VB>(o, vb0, pa0, pa1, pa2, pa3); MASKT(PX0, PX1, (t)); partialSM(PX0, PX1, m_reg, mnX, alX, mwX);             \
        __syncthreads();                                                                                                      \
        if ((t) + 1 < NT) { VMW(); SWRITE_H(SB); }                                                                            \
        RESC(alX); __syncthreads(); } while (0)
    for (int t = 1; t + 1 < NT; t += 2) {
        HALF_STEP(pB0, pB1, mnB, alB, mwB, pA0, pA1, alA, mwA, t, 1, 0, 0);
        HALF_STEP(pA0, pA1, mnA, alA, mwA, pB0, pB1, alB, mwB, t + 1, 0, 1, 1);
    }
    const bool even = (NT & 1) == 0;
    if (even) { mwB = MLOAD(NT - 1); SBAR(); qkt<1>(pB0, pB1, K_lds, r32, hi, S.qr); SBAR(); }
    SLOAD_H(nxt, kbn); SBAR();
#pragma unroll
    for (int d0 = 0; d0 < 8; ++d0) S.qr[d0] = bld8(B.q, vq + d0 * 32, nxt.qo);
    SBAR();
    finishSM(pA0, pA1, alA, l_reg, pa0, pa1, pa2, pa3, mwA); SBAR();
    pv_tile<0>(o, vb0, pa0, pa1, pa2, pa3);
    if (even) { MASKT(pB0, pB1, NT - 1); partialSM(pB0, pB1, m_reg, mnB, alB, mwB); __syncthreads(); RESC(alB);
        finishSM(pB0, pB1, alB, l_reg, pa0, pa1, pa2, pa3, mwB); SBAR(); pv_tile<1>(o, vb0, pa0, pa1, pa2, pa3); }
    SBAR(); SEAM_K0();
    if (hi == 0) li_l[r32] = l_reg; asm volatile("s_waitcnt lgkmcnt(0)" ::: "memory");
    float rli[16];
#pragma unroll
    for (int r = 0; r < 16; ++r) rli[r] = __builtin_amdgcn_rcpf(li_l[crow(r, hi)]);
    const int vo_l = ((wid * QBLK + 4 * hi) * ODM + r32) * 2;
#pragma unroll
    for (int r = 0; r < 16; ++r) {
#pragma unroll
        for (int d0 = 0; d0 < 4; ++d0) { const float v = o[d0][r] * rli[r];
            const float vn = __shfl_xor(v, 1);
            if ((r32 & 1) == 0) __builtin_amdgcn_raw_buffer_store_b32(cvtpk(v, vn), B.o, vo_l, cur.oo + (((r & 3) + 8 * (r >> 2)) * ODM + d0 * 32) * 2, 0); } }
    __syncthreads();
#undef RESC
#undef KBASE
#undef MASKT
#undef SEAM_K0
#undef HALF_STEP
#undef MLOAD
}
#undef ROW
#undef VMW
#undef VMWN
#undef SLOAD_H
#undef SWRITE_HK
#undef SWRITE_HV
#undef SWRITE_H
#undef KSWZ
#undef SBAR
}
constexpr int BATCH = 2, SEQ = 16384, DM = 2048, MT = BATCH * SEQ;
constexpr int AH = 8, AW = 1024, GW = 1024, NINP = 9984, NIN = 9800;
constexpr int NEXP = 16384;
constexpr int NI8 = 36 * 256;
constexpr float EPS = 1e-6f;
constexpr int NWAVES = 8;
constexpr int N_LAUNCHES = MK_N_LAUNCHES;
constexpr int PER_PHASE = 10;
constexpr size_t MiB = 1u << 20;
constexpr size_t WS_CTL = 0, CTL_ZERO_BYTES = 1 * MiB;
constexpr size_t WS_WIN = 2 * MiB, WS_WA = 41 * MiB, WS_WB = 45 * MiB, WS_WO = 49 * MiB, WS_WQ = 57 * MiB, WS_SUBK = 65 * MiB, WS_PU = 66 * MiB  , WS_PV = 98 * MiB  , WS_SU = 130 * MiB, WS_SV = 130 * MiB + 65536;
constexpr size_t WS_WIN8 = 131 * MiB  , WS_SW = 152 * MiB  , WS_SX = 153 * MiB  , WS_XN8 = 937 * MiB  ;
constexpr size_t WS_XN = 194 * MiB, WS_YA = 194 * MiB, WS_YB = 258 * MiB, WS_X1G = 194 * MiB;
constexpr size_t WS_Q = 322 * MiB, WS_K = 386 * MiB, WS_V = 450 * MiB, WS_MIXED = 322 * MiB;
constexpr size_t WS_QI = 514 * MiB, WS_KI = 546 * MiB, WS_WI = 550 * MiB;
constexpr size_t WS_GU = 551 * MiB, WS_GV = 615 * MiB, WS_GA = 679 * MiB, WS_GB = 807 * MiB;
constexpr size_t WS_GVSS = 935 * MiB, WS_MASK = 937 * MiB, WS_X1SS = 1001 * MiB;
constexpr size_t WS_QP = 450 * MiB, WS_EIDX = 578 * MiB, WS_EGATE = 594 * MiB;
constexpr size_t WS_END = 1005 * MiB;
constexpr int CW_TMO = 0, CW_BAR = 4096;

constexpr int RING_OFF = 0, RING_BYTES = 131072;
constexpr int LDSCTL_OFF = RING_BYTES, MISC_OFF = LDSCTL_OFF + 320;
constexpr int LDS_BYTES = 147456;

typedef unsigned short bf16;
typedef unsigned v4u __attribute__((ext_vector_type(4)));
typedef unsigned v2u __attribute__((ext_vector_type(2)));
typedef float f32x4 __attribute__((ext_vector_type(4)));
typedef float f32x16 __attribute__((ext_vector_type(16)));
typedef short bf16x8 __attribute__((ext_vector_type(8)));
typedef __bf16 bf2_t __attribute__((ext_vector_type(2)));
typedef __bf16 bf8_t __attribute__((ext_vector_type(8)));
typedef GAS unsigned gu32;
#define RLX_AGENT __ATOMIC_RELAXED, __HIP_MEMORY_SCOPE_AGENT
#define LDS_WAIT() asm volatile("s_waitcnt lgkmcnt(0)" ::: "memory")
#define VM_WAIT() asm volatile("s_waitcnt vmcnt(0)" ::: "memory")
__device__ __forceinline__ unsigned f2bf(float f) { unsigned u = __builtin_bit_cast(unsigned, f); return (u + 0x7fffu + ((u >> 16) & 1u)) >> 16; }
__device__ __forceinline__ unsigned pk2(float lo, float hi) { return pg8::cvt_pk_bf16(lo, hi); }
__device__ __forceinline__ float bflo(unsigned w) { return __uint_as_float(w << 16); }
__device__ __forceinline__ float bfhi(unsigned w) { return __uint_as_float(w & 0xffff0000u); }
__device__ __forceinline__ float wave_sum(float v) {
#pragma unroll
    for (int o = 1; o < 64; o <<= 1) v += __shfl_xor(v, o);
    return v;
}
__device__ __forceinline__ float gelu_t(float x) {
    const float y2 = x * (1.5957691216f + 0.0713548162726f * x * x);
    const float e = __builtin_amdgcn_exp2f(-1.4426950409f * y2);
    return x * __builtin_amdgcn_rcpf(1.f + e);
}
__device__ __forceinline__ float ub0(unsigned u) { return (float)(u & 255u); }
__device__ __forceinline__ float ub1(unsigned u) { return (float)((u >> 8) & 255u); }
__device__ __forceinline__ float ub2(unsigned u) { return (float)((u >> 16) & 255u); }
__device__ __forceinline__ float ub3(unsigned u) { return (float)(u >> 24); }
__device__ __forceinline__ float sigmoid_f(float x) { return __builtin_amdgcn_rcpf(1.f + __builtin_amdgcn_exp2f(-1.4426950409f * x)); }
__device__ __forceinline__ unsigned sortable(float v) { const unsigned u = __float_as_uint(v + 0.0f); return u ^ ((unsigned)((int)u >> 31) | 0x80000000u); }
__device__ __forceinline__ int crow(int r, int hi) { return (r & 3) + 8 * (r >> 2) + 4 * hi; }
__device__ __forceinline__ unsigned ckey(unsigned sk) { const int ds = (int)(sk ^ 0x80000000u); constexpr int ZK = 190 << 22;
    const int cl = ds < -ZK ? -ZK : (ds > ZK ? ZK : ds); return (unsigned)(ds - cl) ^ 0x80000000u; }

struct Frame {
    LAS unsigned char* lds;
    volatile LAS unsigned* MISC;
    gu32* ctl;
    int tid, lane, wave;
    int vcu, G;
    unsigned char* ws;
    const float* in[15];
    float* out;
};

namespace pg8 {
template <bool I8> struct EpiInProj {
    static constexpr bool PERM = true, AFTER_DRAIN = false;
    unsigned char* ws; int pn_off;
#define IPV(ai, bj, m, n) (I8 ? __builtin_convertvector(__builtin_bit_cast(i32x4_t, acc[ai][bj][m][n]), f32x4) * (swv[bj][n] * sxr[ai][m]) : acc[ai][bj][m][n])
    typedef int i32x4_t __attribute__((ext_vector_type(4)));
    __device__ __forceinline__ void operator()(const f32x4 (&acc)[2][2][4][2], const Unit& u, int wr, int wc, int fr, int fq) const {
        const int pn = u.pn + pn_off, row0 = u.pm * BM + wr * 64 + fr, cw = wc * 32 + 8 * fq;
        f32x4 swv[2][2]; float sxr[2][4];
        if (I8) { const float* sw = (const float*)(ws + WS_SW) + pn * BM + cw; const float* sx = (const float*)(ws + WS_SX) + row0;
#pragma unroll
            for (int bj = 0; bj < 2; ++bj)
#pragma unroll
                for (int n = 0; n < 2; ++n) swv[bj][n] = *(const f32x4*)(sw + bj * HALF + 4 * n);
#pragma unroll
            for (int ai = 0; ai < 2; ++ai)
#pragma unroll
                for (int m = 0; m < 4; ++m) sxr[ai][m] = sx[ai * HALF + m * 16]; }
        if (pn < 12) {
            bf16_t* base = (bf16_t*)(ws + WS_Q + (size_t)(pn >> 2) * (64 * MiB));
#pragma unroll
            for (int ai = 0; ai < 2; ++ai)
#pragma unroll
                for (int m = 0; m < 4; ++m) { const int row = row0 + ai * HALF + m * 16, b = row >> 14, s = row & (SEQ - 1);
#pragma unroll
                    for (int bj = 0; bj < 2; ++bj) { const int head = (pn & 3) * 2 + bj; const f32x4 v0 = IPV(ai, bj, m, 0), v1 = IPV(ai, bj, m, 1);
                        u32x4 w; w.x = cvt_pk_bf16(v0[0], v0[1]); w.y = cvt_pk_bf16(v0[2], v0[3]); w.z = cvt_pk_bf16(v1[0], v1[1]); w.w = cvt_pk_bf16(v1[2], v1[3]);
                        *(u32x4*)(base + ((size_t)(b * AH + head) * SEQ + s) * 128 + cw) = w; } }
        } else if (pn == 38) {
#pragma unroll
            for (int ai = 0; ai < 2; ++ai)
#pragma unroll
                for (int m = 0; m < 4; ++m) { const int row = row0 + ai * HALF + m * 16; const f32x4 v0 = IPV(ai, 0, m, 0), v1 = IPV(ai, 0, m, 1);
                    if (wc < 2) { u32x4 w; w.x = cvt_pk_bf16(v0[0], v0[1]); w.y = cvt_pk_bf16(v0[2], v0[3]); w.z = cvt_pk_bf16(v1[0], v1[1]); w.w = cvt_pk_bf16(v1[2], v1[3]);
                        *(u32x4*)((bf16_t*)(ws + WS_KI) + (size_t)row * 64 + cw) = w; }
                    else if (wc == 2 && fq == 0) { float* wp = (float*)(ws + WS_WI) + (size_t)row * 8; const float sc = 0.35355339059327373f;
                        *(f32x4*)wp = v0 * sc; *(f32x4*)(wp + 4) = v1 * sc; } }
        } else {
            bf16_t* base; int ldc, colt; int mode = 0;
            if (pn >= 36) { base = (bf16_t*)(ws + WS_QI); ldc = 512; colt = (pn - 36) * 256; }
            else if (pn < 16) { base = (bf16_t*)(ws + WS_GU); ldc = 1024; colt = (pn - 12) * 256; mode = 1; }
            else if (pn < 20) { base = (bf16_t*)(ws + WS_GV); ldc = 1024; colt = (pn - 16) * 256; mode = 2; }
            else {
                unsigned char* g8 = ws + (pn < 28 ? WS_GA : WS_GB) + (pn < 28 ? pn - 20 : pn - 28) * 256 + cw;
#pragma unroll
                for (int ai = 0; ai < 2; ++ai)
#pragma unroll
                    for (int m = 0; m < 4; ++m) { const int row = row0 + ai * HALF + m * 16;
#pragma unroll
                        for (int bj = 0; bj < 2; ++bj) { const f32x4 v0 = IPV(ai, bj, m, 0), v1 = IPV(ai, bj, m, 1); v2u w; w.x = 0u; w.y = 0u;
#pragma unroll
                            for (int j = 0; j < 4; ++j) { w.x = __builtin_amdgcn_cvt_pk_u8_f32(255.f * sigmoid_f(v0[j]), j, w.x); w.y = __builtin_amdgcn_cvt_pk_u8_f32(255.f * sigmoid_f(v1[j]), j, w.y); }
                            *(v2u*)(g8 + (size_t)row * 2048 + bj * HALF) = w; } }
                return; }
#pragma unroll
            for (int ai = 0; ai < 2; ++ai)
#pragma unroll
                for (int m = 0; m < 4; ++m) { const int row = row0 + ai * HALF + m * 16; bf16_t* rowp = base + (size_t)row * ldc + colt + cw; float ss = 0.f;
#pragma unroll
                    for (int bj = 0; bj < 2; ++bj) { f32x4 v0 = IPV(ai, bj, m, 0), v1 = IPV(ai, bj, m, 1);
                        if (mode) {
#pragma unroll
                            for (int j = 0; j < 4; ++j) { v0[j] = gelu_t(v0[j]); v1[j] = gelu_t(v1[j]); ss += v0[j] * v0[j] + v1[j] * v1[j]; } }
                        u32x4 w; w.x = cvt_pk_bf16(v0[0], v0[1]); w.y = cvt_pk_bf16(v0[2], v0[3]); w.z = cvt_pk_bf16(v1[0], v1[1]); w.w = cvt_pk_bf16(v1[2], v1[3]);
                        *(u32x4*)(rowp + bj * HALF) = w; }
                    if (mode == 2) { ss += __shfl_xor(ss, 16); ss += __shfl_xor(ss, 32);
                        if (fq == 0) ((float*)(ws + WS_GVSS))[(size_t)row * 16 + (pn - 16) * 4 + wc] = ss; } }
        }
    }
};
#undef IPV
template <bool ACCUM> struct EpiMix {
    static constexpr bool PERM = true, AFTER_DRAIN = false;
    const unsigned char* gate; bf16_t* mixed;
    __device__ __forceinline__ void operator()(const f32x4 (&acc)[2][2][4][2], const Unit& u, int wr, int wc, int fr, int fq) const {
        const int row0 = u.pm * BM + wr * 64 + fr, col0 = u.pn * BM + wc * 32 + 8 * fq;
#pragma unroll
        for (int ai = 0; ai < 2; ++ai) {
            v2u gq[4][2]; u32x4 pq[4][2];
#pragma unroll
            for (int m = 0; m < 4; ++m) { const size_t off = (size_t)(row0 + ai * HALF + m * 16) * DM + col0;
#pragma unroll
                for (int bj = 0; bj < 2; ++bj) { gq[m][bj] = *(const v2u*)(gate + off + bj * HALF); if (ACCUM) pq[m][bj] = *(const u32x4*)(mixed + off + bj * HALF); } }
#pragma unroll
            for (int m = 0; m < 4; ++m) { const size_t off = (size_t)(row0 + ai * HALF + m * 16) * DM + col0;
#pragma unroll
                for (int bj = 0; bj < 2; ++bj) { const v2u g = gq[m][bj]; const f32x4 a0 = acc[ai][bj][m][0] * (1.f / 255.f), a1 = acc[ai][bj][m][1] * (1.f / 255.f);
                    float o[8];
                    o[0] = a0[0] * ub0(g.x); o[1] = a0[1] * ub1(g.x); o[2] = a0[2] * ub2(g.x); o[3] = a0[3] * ub3(g.x);
                    o[4] = a1[0] * ub0(g.y); o[5] = a1[1] * ub1(g.y); o[6] = a1[2] * ub2(g.y); o[7] = a1[3] * ub3(g.y);
                    if (ACCUM) { const u32x4 p = pq[m][bj];
                        o[0] += bflo(p.x); o[1] += bfhi(p.x); o[2] += bflo(p.y); o[3] += bfhi(p.y); o[4] += bflo(p.z); o[5] += bfhi(p.z); o[6] += bflo(p.w); o[7] += bfhi(p.w); }
                    u32x4 w; w.x = cvt_pk_bf16(o[0], o[1]); w.y = cvt_pk_bf16(o[2], o[3]); w.z = cvt_pk_bf16(o[4], o[5]); w.w = cvt_pk_bf16(o[6], o[7]);
                    *(u32x4*)(mixed + off + bj * HALF) = w; } } }
    }
};
struct EpiWo {
    static constexpr bool PERM = true, AFTER_DRAIN = false;
    const float* x; bf16_t* x1; float* ss_out;
    __device__ __forceinline__ void operator()(const f32x4 (&acc)[2][2][4][2], const Unit& u, int wr, int wc, int fr, int fq) const {
        const int row0 = u.pm * BM + wr * 64 + fr, col0 = u.pn * BM + wc * 32 + 8 * fq;
#pragma unroll
        for (int ai = 0; ai < 2; ++ai) {
            f32x4 xq[4][2][2];
#pragma unroll
            for (int m = 0; m < 4; ++m) { const size_t off = (size_t)(row0 + ai * HALF + m * 16) * DM + col0;
#pragma unroll
                for (int bj = 0; bj < 2; ++bj) { xq[m][bj][0] = *(const f32x4*)(x + off + bj * HALF); xq[m][bj][1] = *(const f32x4*)(x + off + bj * HALF + 4); } }
#pragma unroll
            for (int m = 0; m < 4; ++m) { const int row = row0 + ai * HALF + m * 16; const size_t off = (size_t)row * DM + col0; float ss = 0.f;
#pragma unroll
                for (int bj = 0; bj < 2; ++bj) { const f32x4 o0 = xq[m][bj][0] + acc[ai][bj][m][0], o1 = xq[m][bj][1] + acc[ai][bj][m][1];
                    ss += ((o0[0] * o0[0] + o0[1] * o0[1]) + (o0[2] * o0[2] + o0[3] * o0[3])) + ((o1[0] * o1[0] + o1[1] * o1[1]) + (o1[2] * o1[2] + o1[3] * o1[3]));
                    u32x4 w; w.x = cvt_pk_bf16(o0[0], o0[1]); w.y = cvt_pk_bf16(o0[2], o0[3]); w.z = cvt_pk_bf16(o1[0], o1[1]); w.w = cvt_pk_bf16(o1[2], o1[3]);
                    *(u32x4*)(x1 + off + bj * HALF) = w; }
                ss += __shfl_xor(ss, 16); ss += __shfl_xor(ss, 32);
                if (fq == 0) ss_out[(size_t)row * 32 + u.pn * 4 + wc] = ss; } }
    }
};
struct EpiPlainBf16 {
    static constexpr bool PERM = true, AFTER_DRAIN = false;
    bf16_t* O; int ldc;
    __device__ __forceinline__ void operator()(const f32x4 (&acc)[2][2][4][2], const Unit& u, int wr, int wc, int fr, int fq) const {
        const int row0 = u.pm * BM + wr * 64 + fr, col0 = u.pn * BM + wc * 32 + 8 * fq;
#pragma unroll
        for (int ai = 0; ai < 2; ++ai)
#pragma unroll
            for (int m = 0; m < 4; ++m) { bf16_t* rowp = O + (size_t)(row0 + ai * HALF + m * 16) * ldc + col0;
#pragma unroll
                for (int bj = 0; bj < 2; ++bj) { const f32x4 v0 = acc[ai][bj][m][0], v1 = acc[ai][bj][m][1];
                    u32x4 w; w.x = cvt_pk_bf16(v0[0], v0[1]); w.y = cvt_pk_bf16(v0[2], v0[3]); w.z = cvt_pk_bf16(v1[0], v1[1]); w.w = cvt_pk_bf16(v1[2], v1[3]);
                    *(u32x4*)(rowp + bj * HALF) = w; } }
    }
};
}

template <bool WIN>
__device__ __forceinline__ void p0_transpose_item(const float* W, int K, int Nsrc, int Ndst, bf16* WT, LAS float* scr, int item, int lane, const float* ksc = nullptr) {
    const int nblk = Ndst / 32, kb = item / nblk, nb = item % nblk, k0 = 64 * kb, n0 = 32 * nb;
    int src = n0 + (lane & 31);
    if (WIN) { if (src >= 9800) src = -1; else if (src >= 9216) src -= 6144; else if (src >= 3072) src += 584; }
    float tv[32];
#pragma unroll
    for (int i = 0; i < 32; ++i) { const int kk = 2 * i + (lane >> 5); tv[i] = src >= 0 ? W[(size_t)(k0 + kk) * Nsrc + src] : 0.f; }
#pragma unroll
    for (int i = 0; i < 32; ++i) { const int kk = 2 * i + (lane >> 5); scr[kk * 33 + (lane & 31)] = ksc ? tv[i] * ksc[k0 + kk] : tv[i]; }
    LDS_WAIT(); asm volatile("" ::: "memory");
    const int c = lane & 7;
#pragma unroll
    for (int j = 0; j < 4; ++j) { const int n = (lane >> 3) + 8 * j; const LAS float* s = scr + (8 * c) * 33 + n;
        v4u o; o.x = pk2(s[0 * 33], s[1 * 33]); o.y = pk2(s[2 * 33], s[3 * 33]); o.z = pk2(s[4 * 33], s[5 * 33]); o.w = pk2(s[6 * 33], s[7 * 33]);
        *(GAS v4u*)(WT + (size_t)(n0 + n) * K + k0 + 8 * c) = o; }
    LDS_WAIT(); asm volatile("" ::: "memory");
}
__device__ __forceinline__ void p0_convert(const float* src, bf16* dst, size_t n, size_t gtid, size_t gthreads) {
    for (size_t i = gtid * 8; i < n; i += gthreads * 8) { const f32x4 a = *(const GAS f32x4*)(src + i), b = *(const GAS f32x4*)(src + i + 4);
        v4u o; o.x = pk2(a[0], a[1]); o.y = pk2(a[2], a[3]); o.z = pk2(b[0], b[1]); o.w = pk2(b[2], b[3]); *(GAS v4u*)(dst + i) = o; }
}
__device__ __forceinline__ float wave_max(float v) {
#pragma unroll
    for (int o = 1; o < 64; o <<= 1) v = fmaxf(v, __shfl_xor(v, o));
    return v;
}
__device__ __forceinline__ int wave_sum_i(int v) {
#pragma unroll
    for (int o = 1; o < 64; o <<= 1) v += __shfl_xor(v, o);
    return v;
}
__device__ __forceinline__ unsigned pack_q8(float a, float b, float c, float d, float inv, int off) {
    const int qa = (int)__builtin_rintf(a * inv) + off, qb = (int)__builtin_rintf(b * inv) + off, qc = (int)__builtin_rintf(c * inv) + off, qd = (int)__builtin_rintf(d * inv) + off;
    return (unsigned)(qa & 255) | ((unsigned)(qb & 255) << 8) | ((unsigned)(qc & 255) << 16) | ((unsigned)(qd & 255) << 24);
}
constexpr float PEER_CLIP = 0.75f;
__device__ __forceinline__ unsigned pack_q4x8(const float* x, float inv, int off) {
    unsigned w = 0u;
#pragma unroll
    for (int i = 0; i < 8; ++i) { float q = __builtin_rintf(x[i] * inv); q = fminf(fmaxf(q, -7.f), 7.f); const unsigned n = (unsigned)((int)q + off) & 15u; w |= n << (8 * (i >> 1) + 4 * (i & 1)); }
    return w;
}
__device__ __forceinline__ void p0_quant_row(const float* src, unsigned char* dst, float* scale_out, int lane, int off, unsigned xr) {
    const float* r = src + 32 * lane; float x[32]; float am = 0.f;
#pragma unroll
    for (int q = 0; q < 8; ++q) { const f32x4 v = *(const GAS f32x4*)(r + 4 * q); x[4 * q] = v.x; x[4 * q + 1] = v.y; x[4 * q + 2] = v.z; x[4 * q + 3] = v.w;
        am = fmaxf(am, fmaxf(fmaxf(__builtin_fabsf(v.x), __builtin_fabsf(v.y)), fmaxf(__builtin_fabsf(v.z), __builtin_fabsf(v.w)))); }
    am = wave_max(am); const float sc = PEER_CLIP * am * (1.f / 7.f), inv = am > 0.f ? 1.f / sc : 0.f;
    v4u o; o.x = pack_q4x8(x, inv, off); o.y = pack_q4x8(x + 8, inv, off); o.z = pack_q4x8(x + 16, inv, off); o.w = pack_q4x8(x + 24, inv, off);
    o.x ^= xr; o.y ^= xr; o.z ^= xr; o.w ^= xr;
    *(GAS v4u*)(dst + 16 * lane) = o;
    if (lane == 0) *scale_out = sc;
}
__device__ __forceinline__ void p0_prologue(Frame& F) {
    LAS float* scr = (LAS float*)(F.lds + RING_OFF + F.wave * 16384);
    const int gw = F.vcu * NWAVES + F.wave, NGW = F.G * NWAVES;
    constexpr int I_IN = (DM / 64) * (NINP / 32), I_A = (AW / 64) * (DM / 32), I_O = (DM / 64) * (DM / 32);
    constexpr int NITEMS = I_IN + 2 * I_A + 2 * I_O;
    unsigned char* ws = F.ws;
    for (int it = gw; it < NITEMS; it += NGW) {
        int r = it;
        if (r < I_IN) { p0_transpose_item<true>(F.in[2], DM, NIN, NINP, (bf16*)(ws + WS_WIN), scr, r, F.lane); continue; } r -= I_IN;
        if (r < I_A) { p0_transpose_item<false>(F.in[6], AW, DM, DM, (bf16*)(ws + WS_WA), scr, r, F.lane); continue; } r -= I_A;
        if (r < I_A) { p0_transpose_item<false>(F.in[7], GW, DM, DM, (bf16*)(ws + WS_WB), scr, r, F.lane); continue; } r -= I_A;
        if (r < I_O) { p0_transpose_item<false>(F.in[8], DM, DM, DM, (bf16*)(ws + WS_WO), scr, r, F.lane); continue; } r -= I_O;
        p0_transpose_item<false>(F.in[10], DM, DM, DM, (bf16*)(ws + WS_WQ), scr, r, F.lane, F.in[9]);
    }
    const size_t gtid = (size_t)F.vcu * (NWAVES * 64) + F.tid, gthreads = (size_t)F.G * NWAVES * 64;
    p0_convert(F.in[11], (bf16*)(ws + WS_SUBK), (size_t)8 * 2 * 128 * 128, gtid, gthreads);
    for (int r = gw; r < 2 * NEXP; r += NGW) {
        const bool isv = r >= NEXP; const int e = isv ? r - NEXP : r;
        p0_quant_row((isv ? F.in[13] : F.in[12]) + (size_t)e * DM, ws + (isv ? WS_PV : WS_PU) + (size_t)e * (DM / 2), (float*)(ws + (isv ? WS_SV : WS_SU)) + e, F.lane, isv ? 8 : 0, isv ? 0x80808080u : 0u); }
    const float* gm = F.in[1];
    for (int m = gw; m < MT; m += NGW) {
        const GAS f32x4* xr = (const GAS f32x4*)(F.in[0] + (size_t)m * DM) + F.lane;
        f32x4 v[8]; float s = 0.f;
#pragma unroll
        for (int j = 0; j < 8; ++j) { v[j] = xr[64 * j]; s += (v[j].x * v[j].x + v[j].y * v[j].y) + (v[j].z * v[j].z + v[j].w * v[j].w); }
        const float rstd = 1.f / sqrtf(wave_sum(s) * (1.f / DM) + EPS); float am = 0.f;
#pragma unroll
        for (int j = 0; j < 8; ++j) { const f32x4 gg = *((const GAS f32x4*)gm + F.lane + 64 * j); v[j] = v[j] * gg * rstd;
            am = fmaxf(am, fmaxf(fmaxf(__builtin_fabsf(v[j].x), __builtin_fabsf(v[j].y)), fmaxf(__builtin_fabsf(v[j].z), __builtin_fabsf(v[j].w)))); }
        { GAS v2u* o8 = (GAS v2u*)((bf16*)(ws + WS_XN) + (size_t)m * DM) + F.lane;
#pragma unroll
            for (int j = 0; j < 8; ++j) { v2u o; o.x = pk2(v[j].x, v[j].y); o.y = pk2(v[j].z, v[j].w); o8[64 * j] = o; } }
        am = wave_max(am); const float inv = am > 0.f ? 127.f / am : 0.f;
        GAS unsigned* o4 = (GAS unsigned*)(ws + WS_XN8 + (size_t)m * DM) + F.lane;
#pragma unroll
        for (int j = 0; j < 8; ++j) o4[64 * j] = pack_q8(v[j].x, v[j].y, v[j].z, v[j].w, inv, 0);
        if (F.lane == 0) ((float*)(ws + WS_SX))[m] = am * (1.f / 127.f);
    }
}

__device__ __forceinline__ void quant_win_rows(Frame& F) {
    unsigned char* ws = F.ws; const int gw = F.vcu * NWAVES + F.wave, NGW = F.G * NWAVES, lane = F.lane;
    for (int n = gw; n < NI8; n += NGW) { const bf16* r = (const bf16*)(ws + WS_WIN) + (size_t)n * DM + 32 * lane; float x[32]; float am = 0.f;
#pragma unroll
        for (int q = 0; q < 4; ++q) { const v4u v = *(const GAS v4u*)(r + 8 * q); const unsigned wv[4] = {v.x, v.y, v.z, v.w};
#pragma unroll
            for (int w = 0; w < 4; ++w) { x[8 * q + 2 * w] = bflo(wv[w]); x[8 * q + 2 * w + 1] = bfhi(wv[w]); am = fmaxf(am, fmaxf(__builtin_fabsf(x[8 * q + 2 * w]), __builtin_fabsf(x[8 * q + 2 * w + 1]))); } }
        am = wave_max(am); const float inv = am > 0.f ? 127.f / am : 0.f;
        v4u o0, o1;
        o0.x = pack_q8(x[0], x[1], x[2], x[3], inv, 0); o0.y = pack_q8(x[4], x[5], x[6], x[7], inv, 0); o0.z = pack_q8(x[8], x[9], x[10], x[11], inv, 0); o0.w = pack_q8(x[12], x[13], x[14], x[15], inv, 0);
        o1.x = pack_q8(x[16], x[17], x[18], x[19], inv, 0); o1.y = pack_q8(x[20], x[21], x[22], x[23], inv, 0); o1.z = pack_q8(x[24], x[25], x[26], x[27], inv, 0); o1.w = pack_q8(x[28], x[29], x[30], x[31], inv, 0);
        GAS v4u* dst = (GAS v4u*)(ws + WS_WIN8 + (size_t)n * DM + 32 * lane); dst[0] = o0; dst[1] = o1;
        if (lane == 0) ((float*)(ws + WS_SW))[n] = am * (1.f / 127.f); }
}

__device__ __forceinline__ void gmlp_unit(Frame& F, int chunk, int g) {
    constexpr int RS = 272;
    LAS unsigned char* AP = F.lds, * GT = F.lds + 128 * RS; LAS float* rs = (LAS float*)(F.lds + 2 * 128 * RS);
    const int tid = F.tid, lane = F.lane, wid = F.wave, r32 = lane & 31, hi = lane >> 5;
    const int tok0 = chunk * 128; unsigned char* ws = F.ws;
    const int ct = wid & 3;
    const float* gn = F.in[3]; const float* bsp = F.in[5]; const bf16* gup = (const bf16*)(ws + WS_GU); bf16* ybp = (bf16*)(ws + WS_YB);
    f32x4 sq[4]; if (tid < 128) { const f32x4* p = (const f32x4*)((const float*)(ws + WS_GVSS) + (size_t)(tok0 + tid) * 16); sq[0] = p[0]; sq[1] = p[1]; sq[2] = p[2]; sq[3] = p[3]; }
    f32x4 wq[4][2]; { const int t = tid >> 2, s0 = (tid & 3) * 32; const float* w = F.in[4] + ((size_t)g * 128 + t) * 128 + s0;
#pragma unroll
        for (int j = 0; j < 4; ++j) { wq[j][0] = *(const f32x4*)(w + 8 * j); wq[j][1] = *(const f32x4*)(w + 8 * j + 4); } }
    v4u gq[4]; { const bf16* gvp = (const bf16*)(ws + WS_GV);
#pragma unroll
        for (int i = 0; i < 4; ++i) { const int s = (tid >> 4) + 32 * i, c0 = (tid & 15) * 8; gq[i] = *(const v4u*)(gvp + (size_t)(tok0 + s) * GW + g * 128 + c0); } }
    v2u uq[2][4]; f32x4 gg[4]; float bias[2];
#pragma unroll
    for (int q = 0; q < 4; ++q) gg[q] = *(const f32x4*)(gn + g * 128 + 32 * ct + 8 * q + 4 * hi);
#pragma unroll
    for (int t2 = 0; t2 < 2; ++t2) { const int t = 32 * (2 * (wid >> 2) + t2) + r32; bias[t2] = bsp[g * 128 + t];
#pragma unroll
        for (int q = 0; q < 4; ++q) uq[t2][q] = *(const v2u*)(gup + ((size_t)tok0 + t) * GW + g * 128 + 32 * ct + 8 * q + 4 * hi); }
    if (tid < 128) { const f32x4 a = sq[0], b = sq[1], c = sq[2], d = sq[3];
        const float s = ((a.x + a.y) + (a.z + a.w)) + ((b.x + b.y) + (b.z + b.w)) + ((c.x + c.y) + (c.z + c.w)) + ((d.x + d.y) + (d.z + d.w));
        rs[tid] = 1.f / sqrtf(s * (1.f / GW) + EPS); }
    __syncthreads();
    { const int t = tid >> 2, s0 = (tid & 3) * 32;
#pragma unroll
        for (int j = 0; j < 4; ++j) { const f32x4 a = wq[j][0], b = wq[j][1]; float v[8] = {a.x, a.y, a.z, a.w, b.x, b.y, b.z, b.w};
#pragma unroll
            for (int e = 0; e < 8; ++e) { const int s = s0 + 8 * j + e; v[e] = (s <= t) ? v[e] * rs[s] : 0.f; }
            v4u o; o.x = pk2(v[0], v[1]); o.y = pk2(v[2], v[3]); o.z = pk2(v[4], v[5]); o.w = pk2(v[6], v[7]);
            *(LAS v4u*)(AP + t * RS + (s0 + 8 * j) * 2) = o; } }
    {
#pragma unroll
        for (int i = 0; i < 4; ++i) { const int s = (tid >> 4) + 32 * i, c0 = (tid & 15) * 8;
            const unsigned wv[4] = {gq[i].x, gq[i].y, gq[i].z, gq[i].w};
#pragma unroll
            for (int e = 0; e < 8; ++e) *(LAS unsigned short*)(GT + (c0 + e) * RS + s * 2) = (unsigned short)((e & 1) ? (wv[e >> 1] >> 16) : (wv[e >> 1] & 0xffffu)); } }
    __syncthreads();
#pragma unroll
    for (int t2 = 0; t2 < 2; ++t2) { const int tt = 2 * (wid >> 2) + t2; f32x16 acc = {};
#pragma unroll
        for (int ks = 0; ks < 8; ++ks) { const bf16x8 a = *(const LAS bf16x8*)(GT + (32 * ct + r32) * RS + (16 * ks + 8 * hi) * 2), b = *(const LAS bf16x8*)(AP + (32 * tt + r32) * RS + (16 * ks + 8 * hi) * 2);
            acc = __builtin_amdgcn_mfma_f32_32x32x16_bf16(a, b, acc, 0, 0, 0); }
        const int t = 32 * tt + r32; const size_t token = (size_t)tok0 + t;
#pragma unroll
        for (int q = 0; q < 4; ++q) { const int col = g * 128 + 32 * ct + 8 * q + 4 * hi; const v2u uu = uq[t2][q];
            const float y0 = bflo(uu.x) * (acc[4 * q + 0] * gg[q].x + bias[t2]), y1 = bfhi(uu.x) * (acc[4 * q + 1] * gg[q].y + bias[t2]), y2 = bflo(uu.y) * (acc[4 * q + 2] * gg[q].z + bias[t2]), y3 = bfhi(uu.y) * (acc[4 * q + 3] * gg[q].w + bias[t2]);
            v2u o; o.x = pk2(y0, y1); o.y = pk2(y2, y3); *(v2u*)(ybp + token * GW + col) = o; } }
    __syncthreads();
}

constexpr int IX_QL = 0, IX_QROW = 144, IX_HIST = 9 * 32 * IX_QROW  , IX_HROW = 513, IX_MROW = 257, IX_CAND = IX_HIST + 65792, IX_CAP = 64;
constexpr int IX_CCNT = IX_CAND + 32 * IX_CAP * 8, IX_PSTAR = IX_CCNT + 128, IX_NEED = IX_PSTAR + 128, IX_LOF = IX_NEED + 128, IX_FSH = IX_LOF + 128, IX_ABOVE = IX_FSH + 128, IX_FAIL = IX_ABOVE + 128, IX_VLO = IX_FAIL + 16, IX_VHI = IX_VLO + 128, IX_END = IX_VHI + 128;
constexpr int IX_GCAP = 1024;
static_assert(IX_END <= RING_BYTES, "indexer LDS");
#ifndef IX_SAMPLE_MIN
#define IX_SAMPLE_MIN 64
#endif
enum { IXM_SAMPLE = 0, IXM_FULL = 1, IXM_FINE = 2, IXM_EMIT = 3, IXM_CAND = 4 };
__device__ __forceinline__ int ix_cbin(unsigned ck) { const int b = (int)(ck >> 20) - 1536; return b < 0 ? 0 : (b > 1023 ? 1023 : b); }
__device__ __forceinline__ float ix_edge(int cb) {
    if (cb <= 0) return -__builtin_inff(); if (cb > 1023) return __builtin_inff();
    constexpr int ZK = 190 << 22; const int db = (int)(((unsigned)(cb + 1536) << 20) ^ 0x80000000u);
    const int ds = db > 0 ? db + ZK : (db == 0 ? -ZK : db - ZK); const unsigned sk = (unsigned)ds ^ 0x80000000u;
    return __uint_as_float((sk & 0x80000000u) ? (sk ^ 0x80000000u) : ~sk);
}
__device__ __forceinline__ void ix_scan_row(const LAS unsigned* hrow, int K, int lane, int& bstar, int& above, int& total, int& bcnt) {
    unsigned w[8]; int c = 0;
#pragma unroll
    for (int i = 0; i < 8; ++i) { w[i] = hrow[8 * lane + i]; c += (int)(w[i] & 0xffffu) + (int)(w[i] >> 16); }
    int s = c;
#pragma unroll
    for (int off = 1; off < 64; off <<= 1) { const int o = __shfl_down(s, off); if (lane + off < 64) s += o; }
    total = __shfl(s, 0);
    const unsigned long long m = __ballot(s >= K); const int L = m ? 63 - __builtin_clzll(m) : 0;
    int cum = s - c, bs = -1, abv = 0, bc = 0;
#pragma unroll
    for (int i = 7; i >= 0; --i) { const int h1 = (int)(w[i] >> 16), h0 = (int)(w[i] & 0xffffu);
        if (bs < 0) { if (cum + h1 >= K) { bs = 16 * lane + 2 * i + 1; abv = cum; bc = h1; } else cum += h1; }
        if (bs < 0) { if (cum + h0 >= K) { bs = 16 * lane + 2 * i; abv = cum; bc = h0; } else cum += h0; } }
    bstar = __shfl(bs, L); above = __shfl(abv, L); bcnt = __shfl(bc, L);
}
__device__ __forceinline__ void idx_unit(Frame& F, int b, int qb) {
    LAS unsigned char* L = F.lds; unsigned char* ws = F.ws;
    const int tid = F.tid, lane = F.lane, wid = F.wave, r32 = lane & 31, hi = lane >> 5;
    const int t0 = qb * 32; const size_t tokb = (size_t)b * SEQ;
    const bf16* QI = (const bf16*)(ws + WS_QI); const bf16* KI = (const bf16*)(ws + WS_KI); const float* WI = (const float*)(ws + WS_WI);
    LAS unsigned* hist = (LAS unsigned*)(L + IX_HIST); LAS unsigned* ccnt = (LAS unsigned*)(L + IX_CCNT);
    LAS int* pstar_l = (LAS int*)(L + IX_PSTAR); LAS int* need_l = (LAS int*)(L + IX_NEED); LAS int* lof_l = (LAS int*)(L + IX_LOF); LAS int* fsh_l = (LAS int*)(L + IX_FSH);
    LAS unsigned* above_l = (LAS unsigned*)(L + IX_ABOVE); LAS unsigned* fail_l = (LAS unsigned*)(L + IX_FAIL); LAS float* vlo_l = (LAS float*)(L + IX_VLO); LAS float* vhi_l = (LAS float*)(L + IX_VHI);
    unsigned* glist = (unsigned*)(ws + WS_XN) + (size_t)blockIdx.x * (32 * IX_GCAP * 2);
    { const int q = tid >> 4, h = (tid & 15) >> 1, dh = tid & 1; const float w = 0.5f * WI[(tokb + t0 + q) * 8 + h];
        const bf16* src = QI + (tokb + t0 + q) * 512 + h * 64 + dh * 32;
#pragma unroll
        for (int j = 0; j < 4; ++j) { const v4u v = *(const v4u*)(src + 8 * j);
            v4u o; o.x = pk2(bflo(v.x) * w, bfhi(v.x) * w); o.y = pk2(bflo(v.y) * w, bfhi(v.y) * w); o.z = pk2(bflo(v.z) * w, bfhi(v.z) * w); o.w = pk2(bflo(v.w) * w, bfhi(v.w) * w);
            *(LAS v4u*)(L + IX_QL + (h * 32 + q) * IX_QROW + (dh * 32 + 8 * j) * 2) = o; } }
    { const int q = tid >> 4, d4 = (tid & 15) * 4; float a0 = 0.f, a1 = 0.f, a2 = 0.f, a3 = 0.f;
#pragma unroll
        for (int h = 0; h < 8; ++h) { const float w = 0.5f * WI[(tokb + t0 + q) * 8 + h]; const v2u v = *(const v2u*)(QI + (tokb + t0 + q) * 512 + h * 64 + d4);
            a0 += w * bflo(v.x); a1 += w * bfhi(v.x); a2 += w * bflo(v.y); a3 += w * bfhi(v.y); }
        v2u o; o.x = pk2(a0, a1); o.y = pk2(a2, a3); *(LAS v2u*)(L + IX_QL + (8 * 32 + q) * IX_QROW + d4 * 2) = o; }
    unsigned sgm = 0u;
#pragma unroll
    for (int h = 0; h < 8; ++h) sgm |= (WI[(tokb + t0 + r32) * 8 + h] < 0.f ? 1u : 0u) << h;
    unsigned vmask = 0u;
#pragma unroll
    for (int r = 0; r < 16; ++r) vmask |= (crow(r, hi) <= r32 ? 1u : 0u) << r;
    const __amdgpu_buffer_rsrc_t rsG = __builtin_amdgcn_make_buffer_rsrc((void*)glist, 0, 32 * IX_GCAP * 8, 0x00020000);
    if (tid == 0) fail_l[0] = 0u;
    __syncthreads();
    const int ntile = qb + 1, ntile_e = (ntile + 1) & ~1;
    int mode = ntile >= IX_SAMPLE_MIN ? IXM_SAMPLE : IXM_FULL; bool sampled = mode == IXM_SAMPLE, cand_done = false; (void)sampled;
#pragma unroll 1
    for (;;) {
        mode = __builtin_amdgcn_readfirstlane(mode);
        if (mode <= IXM_FINE) { for (int i = tid; i < 32 * IX_HROW; i += NWAVES * 64) hist[i] = 0u; }
        if (tid < 32) { above_l[tid] = 0u; ccnt[tid] = 0u; }
        __syncthreads();
        const int lofq = lof_l[r32], fshq = fsh_l[r32], psq = pstar_l[r32];
        const float vloq = vlo_l[r32], vhiq = vhi_l[r32];
        const int jstep = mode == IXM_SAMPLE ? 8 * NWAVES : NWAVES, jend = mode >= IXM_EMIT ? ntile_e : ntile;
        bf16x8 kf[4], kn[4];
        if (wid < ntile) { const bf16* kp = KI + (tokb + 32 * wid + r32) * 64 + 8 * hi;
#pragma unroll
            for (int ks = 0; ks < 4; ++ks) kn[ks] = *(const bf16x8*)(kp + 16 * ks); }
#pragma unroll 1
        for (int j = wid; j < jend; j += jstep) {
            LAS unsigned short* mrow = (LAS unsigned short*)(hist + (r32 * 2 + hi) * IX_MROW);
            if (j >= ntile) { mrow[j] = 0; continue; }
#pragma unroll
            for (int ks = 0; ks < 4; ++ks) kf[ks] = kn[ks];
            if (j + jstep < ntile) { const bf16* kp = KI + (tokb + 32 * (j + jstep) + r32) * 64 + 8 * hi;
#pragma unroll
                for (int ks = 0; ks < 4; ++ks) kn[ks] = *(const bf16x8*)(kp + 16 * ks); }
            f32x16 sc = {};
            {
                const LAS unsigned char* qbase = L + IX_QL + r32 * IX_QROW + 16 * hi;
#define IX_QLD(dst, h_) do { _Pragma("unroll") for (int ks = 0; ks < 4; ++ks) dst[ks] = *(const LAS bf16x8*)(qbase + (h_) * 32 * IX_QROW + 32 * ks); } while (0)
#define IX_HEAD(qc, h_) do { f32x16 a = {}; _Pragma("unroll") for (int ks = 0; ks < 4; ++ks) a = __builtin_amdgcn_mfma_f32_32x32x16_bf16(kf[ks], qc[ks], a, 0, 0, 0); \
                    if ((h_) < 8) { const float sgf_ = __uint_as_float(0x3f800000u | (((sgm >> ((h_) & 7)) & 1u) << 31)); _Pragma("unroll") for (int r = 0; r < 16; ++r) sc[r] = __builtin_fmaf(__builtin_fabsf(a[r]), sgf_, sc[r]); } \
                    else { _Pragma("unroll") for (int r = 0; r < 16; ++r) sc[r] += a[r]; } \
                    asm volatile("" : "+v"(sc[0]), "+v"(sc[1]), "+v"(sc[2]), "+v"(sc[3]), "+v"(sc[4]), "+v"(sc[5]), "+v"(sc[6]), "+v"(sc[7]), "+v"(sc[8]), "+v"(sc[9]), "+v"(sc[10]), "+v"(sc[11]), "+v"(sc[12]), "+v"(sc[13]), "+v"(sc[14]), "+v"(sc[15])); } while (0)
                bf16x8 qa[4], qb[4];
                IX_QLD(qa, 8);
                IX_QLD(qb, 0); __builtin_amdgcn_sched_barrier(0);
#pragma unroll
                for (int ks = 0; ks < 4; ++ks) sc = __builtin_amdgcn_mfma_f32_32x32x16_bf16(kf[ks], qa[ks], sc, 0, 0, 0);
                __builtin_amdgcn_sched_barrier(0);
                IX_QLD(qa, 1); __builtin_amdgcn_sched_barrier(0); IX_HEAD(qb, 0); __builtin_amdgcn_sched_barrier(0);
                IX_QLD(qb, 2); __builtin_amdgcn_sched_barrier(0); IX_HEAD(qa, 1); __builtin_amdgcn_sched_barrier(0);
                IX_QLD(qa, 3); __builtin_amdgcn_sched_barrier(0); IX_HEAD(qb, 2); __builtin_amdgcn_sched_barrier(0);
                IX_QLD(qb, 4); __builtin_amdgcn_sched_barrier(0); IX_HEAD(qa, 3); __builtin_amdgcn_sched_barrier(0);
                IX_QLD(qa, 5); __builtin_amdgcn_sched_barrier(0); IX_HEAD(qb, 4); __builtin_amdgcn_sched_barrier(0);
                IX_QLD(qb, 6); __builtin_amdgcn_sched_barrier(0); IX_HEAD(qa, 5); __builtin_amdgcn_sched_barrier(0);
                IX_QLD(qa, 7); __builtin_amdgcn_sched_barrier(0); IX_HEAD(qb, 6); __builtin_amdgcn_sched_barrier(0);
                IX_HEAD(qa, 7);
#undef IX_QLD
#undef IX_HEAD
            }
            const bool diag = (j == qb); unsigned bits = 0u;
            LAS unsigned* hrow = hist + r32 * IX_HROW;
            if (mode <= IXM_FULL) {
#pragma unroll
                for (int r = 0; r < 16; ++r) { const bool valid = !diag || (crow(r, hi) <= r32); const unsigned bin = (unsigned)ix_cbin(ckey(sortable(sc[r])));
                    __hip_atomic_fetch_add(hrow + (bin >> 1), valid ? 1u << ((bin & 1u) * 16) : 0u, __ATOMIC_RELAXED, __HIP_MEMORY_SCOPE_WORKGROUP); } }
            else if (mode == IXM_FINE) {
#pragma unroll
                for (int r = 0; r < 16; ++r) { const bool valid = !diag || (crow(r, hi) <= r32); const int d = (int)(ckey(sortable(sc[r])) >> fshq) - lofq; const int dc = d < 1024 ? d : 1024;
                    __hip_atomic_fetch_add(hrow + ((dc >> 1) & 1023), (valid && d >= 0) ? 1u << ((dc & 1) * 16) : 0u, __ATOMIC_RELAXED, __HIP_MEMORY_SCOPE_WORKGROUP); } }
            else if (mode == IXM_CAND) {
                unsigned cge = 0u;
#pragma unroll
                for (int r = 15; r >= 0; --r) asm volatile("v_cmp_ge_f32 vcc, %[v], %[vh]\n\tv_addc_co_u32 %[b], vcc, %[b], %[b], vcc\n\tv_cmp_ge_f32 vcc, %[v], %[vl]\n\tv_addc_co_u32 %[c], vcc, %[c], %[c], vcc"
                    : [b] "+v"(bits), [c] "+v"(cge) : [v] "v"(sc[r]), [vh] "v"(vhiq), [vl] "v"(vloq) : "vcc");
                if (diag) { bits &= vmask; cge &= vmask; }
                const unsigned cb = cge & ~bits;
                if (bits) __hip_atomic_fetch_add(above_l + r32, (unsigned)__builtin_popcount(bits), __ATOMIC_RELAXED, __HIP_MEMORY_SCOPE_WORKGROUP);
                if (__any(cb != 0u)) { const unsigned pc = (unsigned)__builtin_popcount(cb); unsigned base = 0u;
                    if (cb) base = __hip_atomic_fetch_add(ccnt + r32, pc, __ATOMIC_RELAXED, __HIP_MEMORY_SCOPE_WORKGROUP);
                    const unsigned cbx = (base + pc <= (unsigned)IX_GCAP) ? cb : 0u;
                    const unsigned yb = ((unsigned)j << 5) | ((unsigned)hi << 4), qoff = (unsigned)r32 * (IX_GCAP * 8) + base * 8u;
#pragma unroll
                    for (int r = 0; r < 16; ++r) { const unsigned off = ((cbx >> r) & 1u) ? qoff + 8u * (unsigned)__builtin_popcount(cbx & ((1u << r) - 1u)) : 0x7ffffff0u;
                        v2u en; en.x = __float_as_uint(sc[r]); en.y = yb | (unsigned)r;
                        __builtin_amdgcn_raw_buffer_store_b64(en, rsG, off, 0, 0); } } }
            else {
#pragma unroll
                for (int r = 0; r < 16; ++r) { const int kr = crow(r, hi); const bool valid = !diag || (kr <= r32); const unsigned sk = sortable(sc[r]); const int pf = (int)(ckey(sk) >> fshq);
                    bits |= (valid && pf > psq) ? 1u << r : 0u;
                    const bool cand = valid && pf == psq;
                    if (__any(cand)) { if (cand) { const unsigned slot = __hip_atomic_fetch_add(ccnt + r32, 1u, __ATOMIC_RELAXED, __HIP_MEMORY_SCOPE_WORKGROUP);
                            if (slot < (unsigned)IX_CAP) { LAS unsigned* cd = (LAS unsigned*)(L + IX_CAND) + (r32 * IX_CAP + slot) * 2; cd[0] = sk; cd[1] = (unsigned)(32 * j + kr); } } } } }
            if (mode >= IXM_EMIT) mrow[j] = (unsigned short)bits;
        }
        __syncthreads();
        if (mode == IXM_EMIT) break;
        if (mode == IXM_CAND) {
            asm volatile("s_waitcnt vmcnt(0)" ::: "memory"); __syncthreads();
#define IX_RLOAD(raw, q_) do { const int n_ = (int)ccnt[q_]; _Pragma("unroll") for (int i = 0; i < IX_GCAP / 64; ++i) { const int e_ = i * 64 + lane; \
                raw[i] = __builtin_amdgcn_raw_buffer_load_b64(rsG, (e_ < n_ && n_ <= IX_GCAP) ? (unsigned)(((q_) * IX_GCAP + e_) * 8) : 0x7ffffff0u, 0, 0); } } while (0)
            v2u rawc[IX_GCAP / 64]; IX_RLOAD(rawc, wid * 4);
#pragma unroll 1
            for (int qq = 0; qq < 4; ++qq) { const int q = wid * 4 + qq; const int n = (int)ccnt[q], need = 256 - (int)above_l[q];
                v2u rawn[IX_GCAP / 64]; { const int qn = qq + 1 < 4 ? q + 1 : q; IX_RLOAD(rawn, qn); }
                unsigned sk[IX_GCAP / 64], ix[IX_GCAP / 64]; const int nr = (n + 63) >> 6;
#pragma unroll
                for (int i = 0; i < IX_GCAP / 64; ++i) { const bool vd = i * 64 + lane < n; const v2u en = rawc[i]; rawc[i] = rawn[i];
                    sk[i] = vd ? sortable(__uint_as_float(en.x)) : 0u; ix[i] = vd ? (en.y >> 5) * 32u + (unsigned)crow((int)(en.y & 15u), (int)((en.y >> 4) & 1u)) : 0u; }
                if (n > IX_GCAP || need < 1 || need > n) { if (lane == 0) fail_l[0] = 1u; continue; }
                unsigned pre = 0u; int bit0 = 31;
                { unsigned kor = 0u, kand = 0xffffffffu;
#pragma unroll
                    for (int i = 0; i < IX_GCAP / 64; ++i) if (i < nr) { const bool vd = i * 64 + lane < n; kor |= vd ? sk[i] : 0u; kand &= vd ? sk[i] : 0xffffffffu; }
#pragma unroll
                    for (int o = 1; o < 64; o <<= 1) { kor |= (unsigned)__shfl_xor((int)kor, o); kand &= (unsigned)__shfl_xor((int)kand, o); }
                    const unsigned df = kor ^ kand; bit0 = df ? 31 - __builtin_clz(df) : -1; pre = bit0 >= 31 ? 0u : (kand & ~((2u << bit0) - 1u)); if (bit0 < 0) pre = kand; }
#pragma unroll 1
                for (int bit = bit0; bit >= 0; --bit) { const unsigned cd_ = pre | (1u << bit); int cnt = 0;
#pragma unroll
                    for (int i = 0; i < IX_GCAP / 64; ++i) if (i < nr) cnt += __builtin_popcountll(__ballot(sk[i] >= cd_));
                    if (cnt >= need) pre = cd_; }
                int cgt = 0;
#pragma unroll
                for (int i = 0; i < IX_GCAP / 64; ++i) if (i < nr) cgt += __builtin_popcountll(__ballot(sk[i] > pre));
                const int neq = need - cgt; unsigned px = 0u;
                int ceq = 0;
#pragma unroll
                for (int i = 0; i < IX_GCAP / 64; ++i) if (i < nr) ceq += __builtin_popcountll(__ballot(sk[i] == pre && sk[i] != 0u));
                if (ceq == neq) px = 0x3fffu;
                else
#pragma unroll 1
                for (int bit = 13; bit >= 0; --bit) { const unsigned cd_ = px | (1u << bit); int cnt = 0;
#pragma unroll
                    for (int i = 0; i < IX_GCAP / 64; ++i) if (i < nr) cnt += __builtin_popcountll(__ballot(sk[i] == pre && ix[i] < cd_));
                    if (cnt < neq) px = cd_; }
#pragma unroll
                for (int i = 0; i < IX_GCAP / 64; ++i) if (i < nr) { if (sk[i] > pre || (sk[i] == pre && sk[i] != 0u && ix[i] <= px)) { const unsigned mk = ix[i];
                        const int j_ = (int)(mk >> 5), wi = (int)(mk & 31u), h2 = (wi >> 2) & 1, r_ = (wi & 3) + 4 * (wi >> 3);
                        __hip_atomic_fetch_or(hist + (q * 2 + h2) * IX_MROW + (j_ >> 1), 1u << (r_ + 16 * (j_ & 1)), __ATOMIC_RELAXED, __HIP_MEMORY_SCOPE_WORKGROUP); } } }
            __syncthreads();
            if ((unsigned)__builtin_amdgcn_readfirstlane((int)fail_l[0]) == 0u) { cand_done = true; break; }
            __syncthreads(); if (tid == 0) fail_l[0] = 0u; mode = IXM_FULL; sampled = false; continue; }
#pragma unroll 1
        for (int qq = 0; qq < 4; ++qq) { const int q = wid * 4 + qq, t = t0 + q, n = t + 1; int bs, ab, tot, bc;
            if (mode == IXM_FULL) {
                if (n <= 256) { if (lane == 0) { lof_l[q] = 0; fsh_l[q] = 10; } }
                else { ix_scan_row(hist + q * IX_HROW, 256, lane, bs, ab, tot, bc); if (lane == 0) { lof_l[q] = (bs + 1536) << 10; fsh_l[q] = 10; } } }
            else if (mode == IXM_SAMPLE) {
                int bhi, blo, d0, d1, d2; ix_scan_row(hist + q * IX_HROW, 1, lane, bs, ab, tot, bc);
                const float ks = 256.f * (float)tot / (float)n, mg = 4.f * sqrtf(ks) + 4.f;
                int rh = (int)(ks - mg); if (rh < 1) rh = 1; int rl = (int)(ks + mg) + 1; if (rl > tot) rl = tot;
                const bool bad = tot < 64;
                if (!bad) { ix_scan_row(hist + q * IX_HROW, rh, lane, bhi, d0, d1, d2); ix_scan_row(hist + q * IX_HROW, rl, lane, blo, d0, d1, d2); }
                else { bhi = 0; blo = 0; }
                if (lane == 0) { vlo_l[q] = ix_edge(blo); vhi_l[q] = ix_edge(bhi + 1); if (bad) fail_l[0] = 1u; } }
            else {
                if (n <= 256) { if (lane == 0) { pstar_l[q] = -1; need_l[q] = 0; } }
                else { const int need1 = 256 - (int)(hist[q * IX_HROW + 512] & 0xffffu); ix_scan_row(hist + q * IX_HROW, need1 > 0 ? need1 : 1, lane, bs, ab, tot, bc);
                    if (lane == 0) { pstar_l[q] = lof_l[q] + bs; need_l[q] = need1 - ab; } } } }
        __syncthreads();
        const unsigned failw = (unsigned)__builtin_amdgcn_readfirstlane((int)fail_l[0]);
        if (mode == IXM_FINE) mode = IXM_EMIT;
        else if (mode == IXM_FULL) mode = IXM_FINE;
        else { if (failw != 0u) { mode = IXM_FULL; sampled = false; __syncthreads(); if (tid == 0) fail_l[0] = 0u; } else mode = IXM_CAND; }
    }
#pragma unroll 1
    for (int qq = 0; qq < (cand_done ? 0 : 4); ++qq) { const int q = wid * 4 + qq; const int n0_ = (int)ccnt[q]; const int n = n0_ < IX_CAP ? n0_ : IX_CAP, need = need_l[q];
        const LAS unsigned* cd = (const LAS unsigned*)(L + IX_CAND) + q * IX_CAP * 2;
        if (lane < n) { const unsigned ms = cd[lane * 2], mk = cd[lane * 2 + 1]; int rank = 0;
            for (int i = 0; i < n; ++i) { const unsigned s = cd[i * 2], k = cd[i * 2 + 1]; rank += (s > ms || (s == ms && k < mk)) ? 1 : 0; }
            if (rank < need) { const int j = (int)(mk >> 5), wi = (int)(mk & 31u), h2 = (wi >> 2) & 1, r = (wi & 3) + 4 * (wi >> 3);
                __hip_atomic_fetch_or(hist + (q * 2 + h2) * IX_MROW + (j >> 1), 1u << (r + 16 * (j & 1)), __ATOMIC_RELAXED, __HIP_MEMORY_SCOPE_WORKGROUP); } } }
    __syncthreads();
    { unsigned* mw = (unsigned*)(ws + WS_MASK);
        for (int t64 = wid; t64 < ntile_e / 2; t64 += NWAVES)
            mw[((size_t)(b * (SEQ / 64) + t64) * SEQ + t0) * 2 + lane] = hist[lane * IX_MROW + t64]; }
    __syncthreads();
}

constexpr int RT_ROW = 132, RT_SC = 0, RT_TK = 128 * RT_ROW * 4  , RT_TKROW = 17, RT_PT = RT_TK + 128 * RT_TKROW * 4  , RT_END = RT_PT + 64;
#define CE_(a, b) do { const unsigned t_ = (a) > (b) ? (a) : (b); (b) = (a) > (b) ? (b) : (a); (a) = t_; } while (0)
__device__ __forceinline__ void sort16_desc(unsigned (&x)[16]) {
#pragma unroll
    for (int k = 2; k <= 16; k <<= 1)
#pragma unroll
        for (int j = k >> 1; j > 0; j >>= 1)
#pragma unroll
            for (int i = 0; i < 16; ++i) { const int l = i ^ j; if (l > i) { if ((i & k) == 0) CE_(x[i], x[l]); else CE_(x[l], x[i]); } }
}
__device__ __forceinline__ void merge16_desc(unsigned (&L)[16], const unsigned (&N)[16]) {
#pragma unroll
    for (int i = 0; i < 16; ++i) L[i] = L[i] > N[15 - i] ? L[i] : N[15 - i];
#pragma unroll
    for (int j = 8; j > 0; j >>= 1)
#pragma unroll
        for (int i = 0; i < 16; ++i) { const int l = i ^ j; if (l > i) CE_(L[i], L[l]); }
}
template <int CTRL> __device__ __forceinline__ void merge16_dpp(unsigned (&L)[16]) {
    unsigned N[16];
#pragma unroll
    for (int i = 0; i < 16; ++i) N[15 - i] = (unsigned)__builtin_amdgcn_mov_dpp((int)L[i], CTRL, 0xf, 0xf, true);
#pragma unroll
    for (int i = 0; i < 16; ++i) L[i] = L[i] > N[i] ? L[i] : N[i];
#pragma unroll
    for (int j = 8; j > 0; j >>= 1)
#pragma unroll
        for (int i = 0; i < 16; ++i) { const int l = i ^ j; if (l > i) CE_(L[i], L[l]); }
}
__device__ __forceinline__ float unsortable(unsigned k) { return __uint_as_float((k & 0x80000000u) ? (k ^ 0x80000000u) : ~k); }
struct RouteOps { bf16x8 bk[8]; bf16x8 aq[2][8]; };
__device__ __forceinline__ void route_load_bk(Frame& F, int h, RouteOps& R) {
    const int lane = F.lane, wid = F.wave, r32 = lane & 31, hi = lane >> 5, p = wid >> 2, nt = wid & 3;
    const bf16* sp = (const bf16*)(F.ws + WS_SUBK) + ((size_t)((h * 2 + p) * 128 + 32 * nt + r32)) * 128 + 8 * hi;
#pragma unroll
    for (int ks = 0; ks < 8; ++ks) R.bk[ks] = *(const bf16x8*)(sp + 16 * ks);
}
__device__ __forceinline__ void route_load_aq(Frame& F, int tt, int h, RouteOps& R) {
    const int lane = F.lane, wid = F.wave, r32 = lane & 31, hi = lane >> 5, p = wid >> 2;
#pragma unroll
    for (int mt = 0; mt < 2; ++mt) { const bf16* ap = (const bf16*)(F.ws + WS_QP) + (size_t)(tt * 64 + 32 * mt + r32) * DM + h * 256 + p * 128 + 8 * hi;
#pragma unroll
        for (int ks = 0; ks < 8; ++ks) R.aq[mt][ks] = *(const bf16x8*)(ap + 16 * ks); }
}
__device__ __forceinline__ void route_unit(Frame& F, int tt, int h, RouteOps& R, int ttn, int hn) {
    LAS unsigned char* L_ = F.lds; unsigned char* ws = F.ws;
    const int lane = F.lane, wid = F.wave, r32 = lane & 31, hi = lane >> 5; const int tok0 = tt * 64;
    LAS float* SC = (LAS float*)(L_ + RT_SC); LAS unsigned* TK = (LAS unsigned*)(L_ + RT_TK); const LAS unsigned char* PT = (const LAS unsigned char*)(L_ + RT_PT);
    { const int p = wid >> 2, nt = wid & 3;
#pragma unroll
        for (int mt = 0; mt < 2; ++mt) { f32x16 acc = {};
#pragma unroll
            for (int ks = 0; ks < 8; ++ks) acc = __builtin_amdgcn_mfma_f32_32x32x16_bf16(R.aq[mt][ks], R.bk[ks], acc, 0, 0, 0);
#pragma unroll
            for (int r = 0; r < 16; ++r) SC[(p * 64 + 32 * mt + crow(r, hi)) * RT_ROW + 32 * nt + r32] = acc[r]; }
        if (ttn >= 0) { if (hn != h) route_load_bk(F, hn, R); route_load_aq(F, ttn, hn, R); } }
    __syncthreads();
    { const int row = wid * 16 + (lane >> 2), part = lane & 3; unsigned Lk[16], Nk[16];
#pragma unroll
        for (int i = 0; i < 16; ++i) { const int n0 = part + 4 * i, n1 = part + 4 * (16 + i);
            Lk[i] = (sortable(SC[row * RT_ROW + n0]) & ~127u) | (unsigned)(127 - n0); Nk[i] = (sortable(SC[row * RT_ROW + n1]) & ~127u) | (unsigned)(127 - n1); }
        sort16_desc(Lk); sort16_desc(Nk); merge16_desc(Lk, Nk);
        merge16_dpp<0xB1>(Lk); merge16_dpp<0x4E>(Lk);
        if (part == 0) {
#pragma unroll
            for (int i = 0; i < 16; ++i) TK[row * RT_TKROW + i] = Lk[i]; } }
    __syncthreads();
    if (wid < 4) { const int tok = wid * 16 + (lane >> 2), part = lane & 3; unsigned Lk[16];
#pragma unroll
        for (int s = 0; s < 16; ++s) { const int q = 4 * s + part; const int pc = PT[q < 50 ? q : 0]; const int i = pc >> 4, j = pc & 15;
            const float sum = unsortable(TK[tok * RT_TKROW + i] & ~127u) + unsortable(TK[(64 + tok) * RT_TKROW + j] & ~127u);
            Lk[s] = q < 50 ? ((sortable(sum) & ~255u) | (unsigned)(((15 - i) << 4) | (15 - j))) : 0u; }
        sort16_desc(Lk); merge16_dpp<0xB1>(Lk); merge16_dpp<0x4E>(Lk);
        if (part == 0) { const size_t gtok = (size_t)tok0 + tok; const f32x4* sp4 = (const f32x4*)((const float*)(ws + WS_X1SS) + gtok * 32); float ssq = 0.f;
#pragma unroll
            for (int i = 0; i < 8; ++i) { const f32x4 v = sp4[i]; ssq += (v.x + v.y) + (v.z + v.w); }
            const float rl2 = 1.4426950409f / sqrtf(ssq * (1.f / DM) + EPS);
            float ex[16]; int ei[16]; float sm = 0.f; const float mx = unsortable(Lk[0] & ~255u);
#pragma unroll
            for (int k = 0; k < 16; ++k) { const int i = 15 - (int)((Lk[k] >> 4) & 15u), j = 15 - (int)(Lk[k] & 15u);
                ei[k] = (127 - (int)(TK[tok * RT_TKROW + i] & 127u)) * 128 + (127 - (int)(TK[(64 + tok) * RT_TKROW + j] & 127u));
                ex[k] = __builtin_amdgcn_exp2f((unsortable(Lk[k] & ~255u) - mx) * rl2); sm += ex[k]; }
            const float inv = 1.f / sm; int* eo = (int*)(ws + WS_EIDX) + gtok * 128 + h * 16; float* go = (float*)(ws + WS_EGATE) + gtok * 128 + h * 16;
#pragma unroll
            for (int k = 0; k < 4; ++k) { v4u e4; e4.x = (unsigned)ei[4 * k]; e4.y = (unsigned)ei[4 * k + 1]; e4.z = (unsigned)ei[4 * k + 2]; e4.w = (unsigned)ei[4 * k + 3]; *(v4u*)(eo + 4 * k) = e4;
                f32x4 g4; g4.x = ex[4 * k] * inv; g4.y = ex[4 * k + 1] * inv; g4.z = ex[4 * k + 2] * inv; g4.w = ex[4 * k + 3] * inv; *(f32x4*)(go + 4 * k) = g4; } } }
}
__device__ __forceinline__ void route_init(Frame& F) {
    if (F.tid < 64) { int q = F.tid, i = 0; for (; i < 16; ++i) { const int c = 16 / (i + 1); if (q < c) break; q -= c; }
        ((LAS unsigned char*)(F.lds + RT_PT))[F.tid] = (unsigned char)(i < 16 ? ((i << 4) | q) : 0); }
    __syncthreads();
}

constexpr int P9_UNR = 32, P9_UNRA = 32;
#define P9_PIN16(a_, o_) asm volatile("" : "+v"(a_[o_ + 0]), "+v"(a_[o_ + 1]), "+v"(a_[o_ + 2]), "+v"(a_[o_ + 3]), "+v"(a_[o_ + 4]), "+v"(a_[o_ + 5]), "+v"(a_[o_ + 6]), "+v"(a_[o_ + 7]), "+v"(a_[o_ + 8]), "+v"(a_[o_ + 9]), "+v"(a_[o_ + 10]), "+v"(a_[o_ + 11]), "+v"(a_[o_ + 12]), "+v"(a_[o_ + 13]), "+v"(a_[o_ + 14]), "+v"(a_[o_ + 15]))
#define P9_CBAR() do { asm volatile("" ::: "memory"); __builtin_amdgcn_sched_barrier(0); asm volatile("" ::: "memory"); } while (0)
#define P9_ROWHALF(A, B0, W0, W1, C) do { unsigned t0_, t1_; float t2_, t3_, t4_, t5_; asm volatile( \
    "v_and_b32 %[t0], 0x0f0f0f0f, %[w0]\n\tv_lshrrev_b32 %[t1], 4, %[w0]\n\tv_and_b32 %[t1], 0x0f0f0f0f, %[t1]\n\t" \
    "v_cvt_f32_ubyte0 %[t2], %[t0]\n\tv_cvt_f32_ubyte1 %[t3], %[t0]\n\tv_cvt_f32_ubyte2 %[t4], %[t0]\n\tv_cvt_f32_ubyte3 %[t5], %[t0]\n\t" \
    "v_fmac_f32 %[a0], %[c], %[t2]\n\tv_fmac_f32 %[a2], %[c], %[t3]\n\tv_fmac_f32 %[a4], %[c], %[t4]\n\tv_fmac_f32 %[a6], %[c], %[t5]\n\t" \
    "v_cvt_f32_ubyte0 %[t2], %[t1]\n\tv_cvt_f32_ubyte1 %[t3], %[t1]\n\tv_cvt_f32_ubyte2 %[t4], %[t1]\n\tv_cvt_f32_ubyte3 %[t5], %[t1]\n\t" \
    "v_and_b32 %[t0], 0x0f0f0f0f, %[w1]\n\tv_lshrrev_b32 %[t1], 4, %[w1]\n\t" \
    "v_fmac_f32 %[a1], %[c], %[t2]\n\tv_fmac_f32 %[a3], %[c], %[t3]\n\tv_fmac_f32 %[a5], %[c], %[t4]\n\tv_fmac_f32 %[a7], %[c], %[t5]\n\t" \
    "v_and_b32 %[t1], 0x0f0f0f0f, %[t1]\n\t" \
    "v_cvt_f32_ubyte0 %[t2], %[t0]\n\tv_cvt_f32_ubyte1 %[t3], %[t0]\n\tv_cvt_f32_ubyte2 %[t4], %[t0]\n\tv_cvt_f32_ubyte3 %[t5], %[t0]\n\t" \
    "v_fmac_f32 %[a8], %[c], %[t2]\n\tv_fmac_f32 %[a10], %[c], %[t3]\n\tv_fmac_f32 %[a12], %[c], %[t4]\n\tv_fmac_f32 %[a14], %[c], %[t5]\n\t" \
    "v_cvt_f32_ubyte0 %[t2], %[t1]\n\tv_cvt_f32_ubyte1 %[t3], %[t1]\n\tv_cvt_f32_ubyte2 %[t4], %[t1]\n\tv_cvt_f32_ubyte3 %[t5], %[t1]\n\t" \
    "v_fmac_f32 %[a9], %[c], %[t2]\n\tv_fmac_f32 %[a11], %[c], %[t3]\n\tv_fmac_f32 %[a13], %[c], %[t4]\n\tv_fmac_f32 %[a15], %[c], %[t5]" \
    : [a0] "+v"(A[B0 + 0]), [a1] "+v"(A[B0 + 1]), [a2] "+v"(A[B0 + 2]), [a3] "+v"(A[B0 + 3]), [a4] "+v"(A[B0 + 4]), [a5] "+v"(A[B0 + 5]), [a6] "+v"(A[B0 + 6]), [a7] "+v"(A[B0 + 7]), \
      [a8] "+v"(A[B0 + 8]), [a9] "+v"(A[B0 + 9]), [a10] "+v"(A[B0 + 10]), [a11] "+v"(A[B0 + 11]), [a12] "+v"(A[B0 + 12]), [a13] "+v"(A[B0 + 13]), [a14] "+v"(A[B0 + 14]), [a15] "+v"(A[B0 + 15]), \
      [t0] "=&v"(t0_), [t1] "=&v"(t1_), [t2] "=&v"(t2_), [t3] "=&v"(t3_), [t4] "=&v"(t4_), [t5] "=&v"(t5_) : [w0] "v"(W0), [w1] "v"(W1), [c] "s"(C)); } while (0)
#define P9_Q4(A, B0, W0, W1, W2, W3, C4) do { unsigned p0_, p1_, p2_, p3_, t0_, t1_, t2_, t3_, x0_, x1_; asm volatile( \
    "v_perm_b32 %[p0], %[w1], %[w0], %[sa]\n\tv_perm_b32 %[p1], %[w1], %[w0], %[sb]\n\tv_perm_b32 %[p2], %[w3], %[w2], %[sa]\n\tv_perm_b32 %[p3], %[w3], %[w2], %[sb]\n\t" \
    "v_perm_b32 %[t0], %[p2], %[p0], %[sc]\n\tv_perm_b32 %[t1], %[p2], %[p0], %[sd]\n\tv_perm_b32 %[t2], %[p3], %[p1], %[sc]\n\tv_perm_b32 %[t3], %[p3], %[p1], %[sd]\n\t" \
    "v_and_b32 %[x0], 0x0f0f0f0f, %[t0]\n\tv_and_b32 %[x1], 0xf0f0f0f0, %[t0]\n\tv_dot4c_i32_i8_e32 %[a0], %[c], %[x0]\n\tv_dot4c_i32_i8_e32 %[a1], %[c], %[x1]\n\t" \
    "v_and_b32 %[x0], 0x0f0f0f0f, %[t1]\n\tv_and_b32 %[x1], 0xf0f0f0f0, %[t1]\n\tv_dot4c_i32_i8_e32 %[a2], %[c], %[x0]\n\tv_dot4c_i32_i8_e32 %[a3], %[c], %[x1]\n\t" \
    "v_and_b32 %[x0], 0x0f0f0f0f, %[t2]\n\tv_and_b32 %[x1], 0xf0f0f0f0, %[t2]\n\tv_dot4c_i32_i8_e32 %[a4], %[c], %[x0]\n\tv_dot4c_i32_i8_e32 %[a5], %[c], %[x1]\n\t" \
    "v_and_b32 %[x0], 0x0f0f0f0f, %[t3]\n\tv_and_b32 %[x1], 0xf0f0f0f0, %[t3]\n\tv_dot4c_i32_i8_e32 %[a6], %[c], %[x0]\n\tv_dot4c_i32_i8_e32 %[a7], %[c], %[x1]" \
    : [a0] "+v"(A[B0 + 0]), [a1] "+v"(A[B0 + 1]), [a2] "+v"(A[B0 + 2]), [a3] "+v"(A[B0 + 3]), [a4] "+v"(A[B0 + 4]), [a5] "+v"(A[B0 + 5]), [a6] "+v"(A[B0 + 6]), [a7] "+v"(A[B0 + 7]), \
      [p0] "=&v"(p0_), [p1] "=&v"(p1_), [p2] "=&v"(p2_), [p3] "=&v"(p3_), [t0] "=&v"(t0_), [t1] "=&v"(t1_), [t2] "=&v"(t2_), [t3] "=&v"(t3_), [x0] "=&v"(x0_), [x1] "=&v"(x1_) \
    : [w0] "v"(W0), [w1] "v"(W1), [w2] "v"(W2), [w3] "v"(W3), [c] "s"(C4), [sa] "s"(0x05010400u), [sb] "s"(0x07030602u), [sc] "s"(0x05040100u), [sd] "s"(0x07060302u)); } while (0)
__device__ __forceinline__ void peer_sort_tokens4(Frame& F, int tok, LAS v2u* list) {
    unsigned char* ws = F.ws; const int lane = F.lane;
    const float* SU = (const float*)(ws + WS_SU); const float* SV = (const float*)(ws + WS_SV);
    int e0[4], e1[4]; float g0[4], g1[4], su0[4], su1[4], sv0[4], sv1[4];
#pragma unroll
    for (int t = 0; t < 4; ++t) { const int* eip = (const int*)(ws + WS_EIDX) + (size_t)(tok + t) * 128; const float* egp = (const float*)(ws + WS_EGATE) + (size_t)(tok + t) * 128;
        e0[t] = eip[lane]; e1[t] = eip[64 + lane]; g0[t] = egp[lane]; g1[t] = egp[64 + lane]; }
#pragma unroll
    for (int t = 0; t < 4; ++t) { su0[t] = SU[e0[t]]; su1[t] = SU[e1[t]]; sv0[t] = SV[e0[t]]; sv1[t] = SV[e1[t]]; }
    const unsigned long long lt = (lane == 0) ? 0ull : (~0ull >> (64 - lane));
#pragma unroll
    for (int t = 0; t < 4; ++t) {
        const int s0 = e0[t] >> 10, s1 = e1[t] >> 10; int base = 0, p0 = 0, p1 = 0;
#pragma unroll
        for (int s = 0; s < 16; ++s) { const unsigned long long m0 = __ballot(s0 == s), m1 = __ballot(s1 == s); const int c0 = __builtin_popcountll(m0);
            if (s0 == s) p0 = base + __builtin_popcountll(m0 & lt);
            if (s1 == s) p1 = base + c0 + __builtin_popcountll(m1 & lt);
            base += c0 + __builtin_popcountll(m1); }
        v2u a; a.x = (unsigned)e0[t] | (f2bf(su0[t]) << 16); a.y = __float_as_uint(g0[t] * sv0[t]); list[t * 128 + p0] = a;
        v2u b; b.x = (unsigned)e1[t] | (f2bf(su1[t]) << 16); b.y = __float_as_uint(g1[t] * sv1[t]); list[t * 128 + p1] = b; }
}
#ifndef R9
#define R9 32
#endif
#ifndef TB9
#define TB9 4
#endif
#ifndef NSL9
#define NSL9 4
#endif
#ifndef TU9
#define TU9 4
#endif
#ifndef P9_XPACE
#define P9_XPACE 0
#endif
#ifndef P9_WGSYNC
#define P9_WGSYNC 2
#endif
#ifndef UB9
#define UB9 16
#endif
#ifndef P9_STAGGER
#define P9_STAGGER 0
#endif
constexpr int CW_PACE = 200000;
__device__ __forceinline__ void p9_xcc_pace(const XcdBarrier& b) {
    if (b.st == nullptr) return;
    __builtin_amdgcn_s_barrier();
    if (threadIdx.x == 0) { const unsigned nloc = b.st[0];
        if (nloc > 1u) { unsigned* p = b.bar - CW_BAR + CW_PACE + 64 * b.x; const unsigned old = xb_add(p, 1u); const unsigned target = (old / nloc + 1u) * nloc;
            XB_SPIN(xb_ld(p) < target, b.bar); } }
    __builtin_amdgcn_s_barrier();
}
template <int CTRL> __device__ __forceinline__ int p9_dpp(int x) { return __builtin_amdgcn_mov_dpp(x, CTRL, 0xf, 0xf, true); }
__device__ __forceinline__ int p9_reduce16(int (&d)[16], int lane) {
    int e[8], f[4], g[2];
#pragma unroll
    for (int j = 0; j < 8; ++j) { auto r = __builtin_amdgcn_permlane32_swap((unsigned)d[j], (unsigned)d[j + 8], false, false); e[j] = (int)(r[0] + r[1]); }
#pragma unroll
    for (int j = 0; j < 4; ++j) { auto r = __builtin_amdgcn_permlane16_swap((unsigned)e[j], (unsigned)e[j + 4], false, false); f[j] = (int)(r[0] + r[1]); }
    const bool b3 = (lane & 8) != 0, b2 = (lane & 4) != 0;
#pragma unroll
    for (int j = 0; j < 2; ++j) { const int keep = b3 ? f[j + 2] : f[j], send = b3 ? f[j] : f[j + 2]; g[j] = keep + p9_dpp<0x128>(send); }
    const int keep = b2 ? g[1] : g[0], send = b2 ? g[0] : g[1];
    int h = keep + p9_dpp<0x141>(send);
    h += p9_dpp<0x4E>(h); h += p9_dpp<0xB1>(h);
    return h;
}
__device__ __forceinline__ int p9_reduce8(int (&d)[8], int lane) {
    int e[4], f[2];
#pragma unroll
    for (int j = 0; j < 4; ++j) { auto r = __builtin_amdgcn_permlane32_swap((unsigned)d[j], (unsigned)d[j + 4], false, false); e[j] = (int)(r[0] + r[1]); }
#pragma unroll
    for (int j = 0; j < 2; ++j) { auto r = __builtin_amdgcn_permlane16_swap((unsigned)e[j], (unsigned)e[j + 2], false, false); f[j] = (int)(r[0] + r[1]); }
    const bool b3 = (lane & 8) != 0;
    const int keep = b3 ? f[1] : f[0], send = b3 ? f[0] : f[1];
    int h = keep + p9_dpp<0x128>(send);
    h += p9_dpp<0x141>(h); h += p9_dpp<0x4E>(h); h += p9_dpp<0xB1>(h);
    return h;
}
__device__ __forceinline__ void peer_sweep(Frame& F, const XcdBarrier& bar) {
    unsigned char* ws = F.ws; const int lane = F.lane;
    LAS v2u* lists = (LAS v2u*)(F.lds + RING_OFF) + F.wave * (16 * 128);
    const int tokb = (F.vcu * NWAVES + F.wave) * 16;
    const float* x1ss = (const float*)(ws + WS_X1SS);
    const __amdgpu_buffer_rsrc_t rsH = __builtin_amdgcn_make_buffer_rsrc((void*)(ws + WS_X1G), 0, 128 << 20, 0x00020000), rsU = __builtin_amdgcn_make_buffer_rsrc((void*)(ws + WS_PU), 0, 16 << 20, 0x00020000),
        rsV = __builtin_amdgcn_make_buffer_rsrc((void*)(ws + WS_PV), 0, 16 << 20, 0x00020000), rsO = __builtin_amdgcn_make_buffer_rsrc((void*)F.out, 0, 256 << 20, 0x00020000);
    const int vl16 = 16 * lane, vl64 = 64 * lane, vl128 = 128 * lane;
#pragma unroll 1
    for (int tk = 0; tk < 16; tk += 4) peer_sort_tokens4(F, tokb + tk, lists + tk * 128);
    LDS_WAIT(); __builtin_amdgcn_wave_barrier();
    if (F.wave >= 4) { for (int i = 0; i < P9_STAGGER; ++i) __builtin_amdgcn_s_sleep(127); }
#pragma unroll 1
    for (int half = 0; half < 16 / TU9; ++half) {
        int qa[TU9][4], qb[TU9][4]; float sa[TU9];
#pragma unroll
        for (int tk = 0; tk < TU9; ++tk) { const int tok = tokb + half * TU9 + tk;
            const float rstd = 1.f / sqrtf(wave_sum(lane < 32 ? x1ss[(size_t)tok * 32 + lane] : 0.f) * (1.f / DM) + EPS);
            v4u hb[4]; float hf[32]; float am = 0.f;
#pragma unroll
            for (int q = 0; q < 4; ++q) hb[q] = __builtin_amdgcn_raw_buffer_load_b128(rsH, vl64 + 16 * q, tok * 4096, 0);
            f32x4 gq[8]; { int zo; asm volatile("s_mov_b32 %0, 0" : "=s"(zo)); const float* gp = F.in[9] + 32 * lane + zo;
#pragma unroll
                for (int q = 0; q < 8; ++q) gq[q] = *(const f32x4*)(gp + 4 * q); }
#pragma unroll
            for (int q = 0; q < 4; ++q) { const unsigned wv[4] = {hb[q].x, hb[q].y, hb[q].z, hb[q].w};
#pragma unroll
                for (int w = 0; w < 4; ++w) { hf[8 * q + 2 * w] = bflo(wv[w]) * gq[2 * q + (w >> 1)][2 * (w & 1)]; hf[8 * q + 2 * w + 1] = bfhi(wv[w]) * gq[2 * q + (w >> 1)][2 * (w & 1) + 1]; am = fmaxf(am, fmaxf(__builtin_fabsf(hf[8 * q + 2 * w]), __builtin_fabsf(hf[8 * q + 2 * w + 1]))); } }
            am = wave_max(am); const float inv = am > 0.f ? 119.f / am : 0.f; sa[tk] = rstd * am * (1.f / 119.f);
#pragma unroll
            for (int w = 0; w < 4; ++w) { unsigned A = 0u, B = 0u;
#pragma unroll
                for (int i = 0; i < 8; ++i) { const int q = (int)__builtin_rintf(hf[8 * w + i] * inv); const int a = (q + 8) >> 4, b = q - (a << 4);
                    A |= ((unsigned)a & 15u) << (4 * i); B |= ((unsigned)b & 15u) << (4 * i); }
                qa[tk][w] = (int)A; qb[tk][w] = (int)B; }
            P9_CBAR(); }
#define U_LOAD(buf, en_, s_) do { const LAS v2u* lp_ = lists + (half * TU9 + ((s_) % TU9)) * 128 + ((s_) / TU9) * UB9; en_ = lp_[lane / (64 / UB9)]; \
            _Pragma("unroll") for (int u = 0; u < UB9; ++u) { const int e_ = __builtin_amdgcn_readlane((int)(en_.x & 0x3fffu), (64 / UB9) * u); buf[u] = __builtin_amdgcn_raw_buffer_load_b128(rsU, vl16, e_ * 1024, 0); } } while (0)
#define U_DOT(buf, en_, s_) do { int d[UB9]; \
            _Pragma("unroll") for (int u = 0; u < UB9; ++u) { int dd = 0; const int wv[4] = {(int)buf[u].x, (int)buf[u].y, (int)buf[u].z, (int)buf[u].w}; \
                _Pragma("unroll") for (int w = 0; w < 4; ++w) dd = __builtin_amdgcn_sdot8(wv[w], qa[(s_) % TU9][w], dd, false); \
                dd <<= 4; \
                _Pragma("unroll") for (int w = 0; w < 4; ++w) dd = __builtin_amdgcn_sdot8(wv[w], qb[(s_) % TU9][w], dd, false); \
                d[u] = dd; } \
            const int dsum = UB9 == 16 ? p9_reduce16((int (&)[16])d, lane) : p9_reduce8((int (&)[8])d, lane); \
            if ((lane & (64 / UB9 - 1)) == 0 && pxu == 1) { LAS v2u* lp_ = lists + (half * TU9 + ((s_) % TU9)) * 128 + ((s_) / TU9) * UB9; const float act = (float)dsum * (__uint_as_float(en_.x & 0xffff0000u) * sa[(s_) % TU9]); \
                v2u o; o.x = en_.x; o.y = __float_as_uint(__uint_as_float(en_.y) * gelu_t(act)); lp_[lane / (64 / UB9)] = o; } } while (0)
#if P9_XPACE >= 1
        p9_xcc_pace(bar);
#endif
#ifdef PROBE_XU
        int pxu_n; asm volatile("s_mov_b32 %0, 2" : "=s"(pxu_n));
#pragma unroll 1
        for (int pxu = 0; pxu < pxu_n; ++pxu)
#else
        const int pxu = 1;
#endif
        { v4u bA[UB9], bB[UB9]; v2u enA, enB; constexpr int NS = TU9 * 32 / UB9;
            U_LOAD(bA, enA, 0); P9_CBAR();
#pragma unroll 1
            for (int b = 0; b < 4; ++b) {
#ifdef P9_WGSYNC
                __builtin_amdgcn_s_barrier();
#endif
                const LAS v2u* lists0 = lists; lists += b * 32;
#pragma unroll
                for (int s = 0; s < NS; s += 2) {
#if defined(P9_WGSYNC) && P9_WGSYNC >= 3
                    if (s > 0) __builtin_amdgcn_s_barrier();
#elif defined(P9_WGSYNC) && P9_WGSYNC >= 2
                    if (s == NS / 2) __builtin_amdgcn_s_barrier();
#endif
                    U_LOAD(bB, enB, s + 1); P9_CBAR(); U_DOT(bA, enA, s); P9_CBAR();
                    if (s + 2 < NS) { U_LOAD(bA, enA, s + 2); } else if (b + 1 < 4) { lists += 32; U_LOAD(bA, enA, 0); lists -= 32; }
                    P9_CBAR(); U_DOT(bB, enB, s + 1); P9_CBAR(); }
                lists = (LAS v2u*)lists0; } }
#undef U_LOAD
#undef U_DOT
    }
    LDS_WAIT(); __builtin_amdgcn_wave_barrier();
#pragma unroll 1
    for (int grp = 0; grp < 16 / TB9; ++grp) {
        int acc[TB9][32]; float csc[TB9]; int cs8[TB9];
#pragma unroll
        for (int tk = 0; tk < TB9; ++tk) {
            LAS v2u* lp = lists + (grp * TB9 + tk) * 128; const v2u ea = lp[lane], eb = lp[64 + lane];
            const float c0 = __uint_as_float(ea.y), c1 = __uint_as_float(eb.y);
            const float am = wave_max(fmaxf(__builtin_fabsf(c0), __builtin_fabsf(c1))); const float inv = am > 0.f ? 127.f / am : 0.f; csc[tk] = am * (1.f / 127.f);
            const int q0 = (int)__builtin_rintf(c0 * inv), q1 = (int)__builtin_rintf(c1 * inv);
            cs8[tk] = (int)wave_sum((float)(q0 + q1));
            LAS unsigned* wq = (LAS unsigned*)lp; LAS unsigned char* wb = (LAS unsigned char*)lp;
            asm volatile("" ::: "memory");
            wq[lane] = ea.x & 0x3fffu; wq[64 + lane] = eb.x & 0x3fffu; wb[512 + lane] = (unsigned char)q0; wb[576 + lane] = (unsigned char)q1;
#pragma unroll
            for (int i = 0; i < 32; ++i) acc[tk][i] = 0; }
        LDS_WAIT(); __builtin_amdgcn_wave_barrier();
#if P9_XPACE >= 1
        p9_xcc_pace(bar);
#endif
        static_assert(TB9 == 2 || TB9 == 4, "v sweep: two or four tokens per pass");
        constexpr int NQ = TB9 * 8;
        const LAS unsigned* idp = (const LAS unsigned*)(lists + grp * TB9 * 128) + (lane >> 5) * 256 + (lane & 31);
        const LAS unsigned* cqp = (const LAS unsigned*)(lists + grp * TB9 * 128) + ((lane >> 3) & (TB9 - 1)) * 256 + 128 + (lane & 7);
#define V_TK(q_) (((q_) >> 2) % TB9)
#define V_H(q_) ((q_) / (TB9 * 4))
#define V_LD4(slot, idr, q_) do { _Pragma("unroll") for (int r = 0; r < 4; ++r) { const int e_ = __builtin_amdgcn_readlane((int)(idr[V_TK(q_) >> 1]), (V_TK(q_) & 1) * 32 + V_H(q_) * 16 + ((q_) & 3) * 4 + r); \
            sl[slot][r] = __builtin_amdgcn_raw_buffer_load_b128(rsV, vl16, e_ * 1024, 0); } } while (0)
#define V_AC4(slot, q_) do { const int c4 = __builtin_amdgcn_readlane((int)cqc, V_TK(q_) * 8 + V_H(q_) * 4 + ((q_) & 3)) & cmask; \
            P9_Q4(acc[V_TK(q_)], 0, sl[slot][0].x, sl[slot][1].x, sl[slot][2].x, sl[slot][3].x, c4); P9_Q4(acc[V_TK(q_)], 8, sl[slot][0].y, sl[slot][1].y, sl[slot][2].y, sl[slot][3].y, c4); \
            P9_Q4(acc[V_TK(q_)], 16, sl[slot][0].z, sl[slot][1].z, sl[slot][2].z, sl[slot][3].z, c4); P9_Q4(acc[V_TK(q_)], 24, sl[slot][0].w, sl[slot][1].w, sl[slot][2].w, sl[slot][3].w, c4); \
            asm volatile("s_nop 4"); } while (0)
#ifdef PROBE_XV
        int pxv_n; asm volatile("s_mov_b32 %0, 2" : "=s"(pxv_n));
#pragma unroll 1
        for (int pxv = 0; pxv < pxv_n; ++pxv)
#else
        const int pxv = 1;
#endif
        { v4u sl[NSL9][4]; const int cmask = pxv == 1 ? -1 : 0; unsigned idc[TB9 / 2], idn[TB9 / 2];
#pragma unroll
            for (int t = 0; t < TB9 / 2; ++t) idc[t] = idp[t * 512];
#pragma unroll
            for (int q = 0; q < NSL9; ++q) V_LD4(q, idc, q);
            P9_CBAR();
#pragma unroll 1
            for (int b = 0; b < 4; ++b) {
#if P9_WGSYNC >= 1
                __builtin_amdgcn_s_barrier();
#endif
                const unsigned cqc = cqp[b * 8];
#pragma unroll
                for (int t = 0; t < TB9 / 2; ++t) idn[t] = idp[t * 512 + (b + 1 < 4 ? b + 1 : 3) * 32];
#pragma unroll
                for (int q = 0; q < NQ; ++q) {
#if P9_WGSYNC >= 2
                    if (q == NQ / 2) __builtin_amdgcn_s_barrier();
#endif
                    V_AC4(q % NSL9, q); P9_CBAR();
                    if (q + NSL9 < NQ) { V_LD4(q % NSL9, idc, q + NSL9); } else if (b + 1 < 4) { V_LD4(q % NSL9, idn, q + NSL9 - NQ); }
                    P9_CBAR(); }
#pragma unroll
                for (int t = 0; t < TB9 / 2; ++t) idc[t] = idn[t]; } }
#undef V_LD4
#undef V_AC4
#undef V_TK
#undef V_H
#pragma unroll
        for (int tk = 0; tk < TB9; ++tk) { const int tok = tokb + grp * TB9 + tk; const int cz = 8 * cs8[tk]; const float se = csc[tk], so = csc[tk] * (1.f / 16.f);
            int zopq; asm volatile("s_mov_b32 %0, 0" : "=s"(zopq));
            const float* gf = F.in[14] + 32 * lane + zopq; float ss = 0.f; float fa[32]; v4u xb[4];
#pragma unroll
            for (int q = 0; q < 4; ++q) xb[q] = __builtin_amdgcn_raw_buffer_load_b128(rsH, vl64 + 16 * q, tok * 4096, 0);
#pragma unroll
            for (int q = 0; q < 8; ++q) { f32x4 a; { const v4u hq = xb[q >> 1]; const unsigned w0 = (q & 1) ? hq.z : hq.x, w1 = (q & 1) ? hq.w : hq.y; a.x = bflo(w0); a.y = bfhi(w0); a.z = bflo(w1); a.w = bfhi(w1); } const int ai = 4 * q;
                fa[ai] = __builtin_fmaf((float)(acc[tk][ai] - cz), se, a.x); fa[ai + 1] = __builtin_fmaf((float)acc[tk][ai + 1], so, a.y);
                fa[ai + 2] = __builtin_fmaf((float)(acc[tk][ai + 2] - cz), se, a.z); fa[ai + 3] = __builtin_fmaf((float)acc[tk][ai + 3], so, a.w);
                ss += (fa[ai] * fa[ai] + fa[ai + 1] * fa[ai + 1]) + (fa[ai + 2] * fa[ai + 2] + fa[ai + 3] * fa[ai + 3]); }
            const float rf = 1.f / sqrtf(wave_sum(ss) * (1.f / DM) + EPS);
#pragma unroll
            for (int q = 0; q < 8; ++q) { const f32x4 g4 = *(const f32x4*)(gf + 4 * q); const int ai = 4 * q;
                f32x4 o; o.x = fa[ai] * rf * g4.x; o.y = fa[ai + 1] * rf * g4.y; o.z = fa[ai + 2] * rf * g4.z; o.w = fa[ai + 3] * rf * g4.w;
                __builtin_amdgcn_raw_buffer_store_b128(__builtin_bit_cast(v4u, o), rsO, vl128 + 16 * q, tok * 8192, 0); }
            P9_CBAR(); }
    }
}
__device__ __forceinline__ void peer_token2(Frame& F, int tok, LAS float* cbuf) {
    unsigned char* ws = F.ws; const int lane = F.lane;
    const float* x1ss = (const float*)(ws + WS_X1SS);
    const float rstd = 1.f / sqrtf(wave_sum(lane < 32 ? x1ss[(size_t)tok * 32 + lane] : 0.f) * (1.f / DM) + EPS);
    const __amdgpu_buffer_rsrc_t rsH = __builtin_amdgcn_make_buffer_rsrc((void*)(ws + WS_X1G), 0, 128 << 20, 0x00020000), rsU = __builtin_amdgcn_make_buffer_rsrc((void*)(ws + WS_PU), 0, 16 << 20, 0x00020000),
        rsV = __builtin_amdgcn_make_buffer_rsrc((void*)(ws + WS_PV), 0, 16 << 20, 0x00020000), rsO = __builtin_amdgcn_make_buffer_rsrc((void*)F.out, 0, 256 << 20, 0x00020000);
    const int vl16 = 16 * lane, vl64 = 64 * lane, vl128 = 128 * lane;
    int qlo[4], qhi[4]; float sh;
    { v4u hb[4]; float hf[32]; float am = 0.f;
#pragma unroll
        for (int q = 0; q < 4; ++q) hb[q] = __builtin_amdgcn_raw_buffer_load_b128(rsH, vl64 + 16 * q, tok * 4096, 0);
        f32x4 gq[8];
#pragma unroll
        for (int q = 0; q < 8; ++q) gq[q] = *(const f32x4*)(F.in[9] + 32 * lane + 4 * q);
#pragma unroll
        for (int q = 0; q < 4; ++q) { const unsigned wv[4] = {hb[q].x, hb[q].y, hb[q].z, hb[q].w};
#pragma unroll
            for (int w = 0; w < 4; ++w) { hf[8 * q + 2 * w] = bflo(wv[w]) * gq[2 * q + (w >> 1)][2 * (w & 1)]; hf[8 * q + 2 * w + 1] = bfhi(wv[w]) * gq[2 * q + (w >> 1)][2 * (w & 1) + 1]; am = fmaxf(am, fmaxf(__builtin_fabsf(hf[8 * q + 2 * w]), __builtin_fabsf(hf[8 * q + 2 * w + 1]))); } }
        am = wave_max(am); const float inv = am > 0.f ? 127.f / am : 0.f; sh = am * (1.f / 127.f);
#pragma unroll
        for (int w = 0; w < 4; ++w) { qlo[w] = (int)pack_q8(hf[8 * w], hf[8 * w + 2], hf[8 * w + 4], hf[8 * w + 6], inv, 0); qhi[w] = (int)pack_q8(hf[8 * w + 1], hf[8 * w + 3], hf[8 * w + 5], hf[8 * w + 7], inv, 0); } }
    const float sa = rstd * sh * (1.f / 16.f);
    const int* eip = (const int*)(ws + WS_EIDX) + (size_t)tok * 128; const float* egp = (const float*)(ws + WS_EGATE) + (size_t)tok * 128;
    const int e0 = eip[lane], e1 = eip[64 + lane]; const float g0 = egp[lane], g1 = egp[64 + lane];
    const float* SU = (const float*)(ws + WS_SU); const float* SV = (const float*)(ws + WS_SV);
    const float su0 = SU[e0], su1 = SU[e1], sv0 = SV[e0], sv1 = SV[e1];
#define T2_LOAD(buf, rs, kk_) do { _Pragma("unroll") for (int u = 0; u < 16; ++u) { const int e_ = __builtin_amdgcn_readlane((kk_) < 64 ? e0 : e1, ((kk_) + u) & 63); buf[u] = __builtin_amdgcn_raw_buffer_load_b128(rs, vl16, e_ * 1024, 0); } } while (0)
#define T2_DOT(buf, kk_) do { int d[16]; _Pragma("unroll") for (int u = 0; u < 16; ++u) { int dd = 0; const unsigned wv[4] = {buf[u].x, buf[u].y, buf[u].z, buf[u].w}; \
        _Pragma("unroll") for (int w = 0; w < 4; ++w) { dd = __builtin_amdgcn_sdot4((int)((wv[w] << 4) & 0xf0f0f0f0u), qlo[w], dd, false); dd = __builtin_amdgcn_sdot4((int)(wv[w] & 0xf0f0f0f0u), qhi[w], dd, false); } d[u] = dd; } \
        _Pragma("unroll") for (int o = 1; o < 64; o <<= 1) { _Pragma("unroll") for (int u = 0; u < 16; ++u) d[u] += __shfl_xor(d[u], o); } \
        const int myu = (lane - (kk_)) & 63; int dsel = 0; _Pragma("unroll") for (int u = 0; u < 16; ++u) dsel = (myu == u) ? d[u] : dsel; \
        if (myu < 16) { const float act = (float)dsel * (((kk_) < 64 ? su0 : su1) * sa); cbuf[(kk_) + myu] = ((kk_) < 64 ? g0 : g1) * gelu_t(act) * ((kk_) < 64 ? sv0 : sv1); } } while (0)
#define T2_ACC(buf, kk_) do { _Pragma("unroll") for (int u = 0; u < 16; ++u) { const float c = __uint_as_float(__builtin_amdgcn_readfirstlane((int)__float_as_uint(cbuf[(kk_) + u]))); csum += c; \
        P9_ROWHALF(acc, 0, buf[u].x ^ 0x80808080u, buf[u].y ^ 0x80808080u, c); P9_ROWHALF(acc, 16, buf[u].z ^ 0x80808080u, buf[u].w ^ 0x80808080u, c); } } while (0)
    { v4u bA[16], bB[16];
        T2_LOAD(bA, rsU, 0); P9_CBAR();
#pragma unroll 1
        for (int kk = 0; kk < 128; kk += 32) {
            T2_LOAD(bB, rsU, kk + 16); P9_CBAR(); T2_DOT(bA, kk); P9_CBAR();
            if (kk + 32 < 128) { T2_LOAD(bA, rsU, kk + 32); } P9_CBAR(); T2_DOT(bB, kk + 16); P9_CBAR(); } }
    LDS_WAIT(); __builtin_amdgcn_wave_barrier();
    float acc[32]; float csum = 0.f;
#pragma unroll
    for (int i = 0; i < 32; ++i) acc[i] = 0.f;
    { v4u bA[16], bB[16];
        T2_LOAD(bA, rsV, 0); P9_CBAR();
#pragma unroll 1
        for (int kk = 0; kk < 128; kk += 32) {
            T2_LOAD(bB, rsV, kk + 16); P9_CBAR(); T2_ACC(bA, kk); P9_CBAR();
            if (kk + 32 < 128) { T2_LOAD(bA, rsV, kk + 32); } P9_CBAR(); T2_ACC(bB, kk + 16); P9_CBAR(); } }
#undef T2_LOAD
#undef T2_DOT
#undef T2_ACC
    LDS_WAIT(); __builtin_amdgcn_wave_barrier();
    const float cz = -8.f * csum;
    int zopq; asm volatile("s_mov_b32 %0, 0" : "=s"(zopq));
    const float* gf = F.in[14] + 32 * lane + zopq; float ss = 0.f; v4u xb[4];
#pragma unroll
    for (int q = 0; q < 4; ++q) xb[q] = __builtin_amdgcn_raw_buffer_load_b128(rsH, vl64 + 16 * q, tok * 4096, 0);
#pragma unroll
    for (int q = 0; q < 8; ++q) { f32x4 a; { const v4u hq = xb[q >> 1]; const unsigned w0 = (q & 1) ? hq.z : hq.x, w1 = (q & 1) ? hq.w : hq.y; a.x = bflo(w0); a.y = bfhi(w0); a.z = bflo(w1); a.w = bfhi(w1); } const int ai = 4 * q;
        acc[ai] += a.x + cz; acc[ai + 1] += a.y + cz; acc[ai + 2] += a.z + cz; acc[ai + 3] += a.w + cz; ss += (acc[ai] * acc[ai] + acc[ai + 1] * acc[ai + 1]) + (acc[ai + 2] * acc[ai + 2] + acc[ai + 3] * acc[ai + 3]); }
    const float rf = 1.f / sqrtf(wave_sum(ss) * (1.f / DM) + EPS);
#pragma unroll
    for (int q = 0; q < 8; ++q) { const f32x4 gg = *(const f32x4*)(gf + 4 * q); const int ai = 4 * q;
        f32x4 o; o.x = acc[ai] * rf * gg.x; o.y = acc[ai + 1] * rf * gg.y; o.z = acc[ai + 2] * rf * gg.z; o.w = acc[ai + 3] * rf * gg.w;
        __builtin_amdgcn_raw_buffer_store_b128(__builtin_bit_cast(v4u, o), rsO, vl128 + 16 * q, tok * 8192, 0); }
}
#undef P9_PIN16
#undef P9_CBAR
#undef P9_ROWHALF
#undef P9_Q4

#ifndef G4_ALIGN
#define G4_ALIGN true
#endif
#ifndef G4_SP2
#define G4_SP2 true
#endif
__device__ __forceinline__ void phase0(Frame& F, unsigned char* lds) {
    unsigned char* ws = F.ws;
 p0_prologue(F);
}
__device__ __forceinline__ void phase1(Frame& F, unsigned char* lds, const XcdBarrier& bar) {
    unsigned char* ws = F.ws;
    quant_win_rows(F); xcd_barrier(bar);
    { pg8::Gemm g{(const pg8::bf16_t*)(ws + WS_XN8), (const pg8::bf16_t*)(ws + WS_WIN8), MT, NI8, DM / 2}; pg8::StaticOrder S; S.init(MT, NI8, F.G, (int)blockIdx.x);
      pg8::EpiInProj<true> E{ws, 0};
      pg8::gemm_phase<pg8::EpiInProj<true>, pg8::StaticOrder, true, true, true>(F.lds + RING_OFF, g, S, E); }
    { pg8::Gemm g{(const pg8::bf16_t*)(ws + WS_XN), (const pg8::bf16_t*)(ws + WS_WIN) + (size_t)NI8 * DM, MT, NINP - NI8, DM}; pg8::StaticOrder S; S.init(MT, NINP - NI8, F.G, (int)blockIdx.x);
      pg8::EpiInProj<false> E{ws, NI8 / 256};
      pg8::gemm_phase<pg8::EpiInProj<false>, pg8::StaticOrder, true, true, false>(F.lds + RING_OFF, g, S, E); }
}
__device__ __forceinline__ void phase2(Frame& F, unsigned char* lds) {
    unsigned char* ws = F.ws;
#ifndef REPEAT_MASK
#define REPEAT_MASK 0
#endif
#pragma unroll 1
        for (int rep_ = 0; rep_ < 1 + ((REPEAT_MASK >> 10) & 1); ++rep_)
        for (int i = F.vcu; i < 1024; i += F.G) { const int b = i >> 9, x = i & 511; const int qb = (x >> 8) ? 511 - (x & 255) : (x & 255); idx_unit(F, b, qb); }
#pragma unroll 1
        for (int rep_ = 0; rep_ < 1 + ((REPEAT_MASK >> 11) & 1); ++rep_)
        for (int i = F.vcu; i < 2048; i += F.G) gmlp_unit(F, i >> 3, i & 7);

}
__device__ __forceinline__ void phase3(Frame& F, unsigned char* lds) {
    unsigned char* ws = F.ws;
        const int total = BATCH * AH * 32;
        int Lc = F.vcu;
        if (Lc < total) {
            att::Bufs AB;
            AB.q = __builtin_amdgcn_make_buffer_rsrc((void*)(ws + WS_Q), 0, 64 << 20, 0x00020000); AB.k = __builtin_amdgcn_make_buffer_rsrc((void*)(ws + WS_K), 0, 64 << 20, 0x00020000);
            AB.v = __builtin_amdgcn_make_buffer_rsrc((void*)(ws + WS_V), 0, 64 << 20, 0x00020000); AB.o = __builtin_amdgcn_make_buffer_rsrc((void*)(ws + WS_YA), 0, 64 << 20, 0x00020000);
            AB.m = __builtin_amdgcn_make_buffer_rsrc((void*)(ws + WS_MASK), 0, 64 << 20, 0x00020000);
#define ATT_REF(R, L_, pass_) do { const unsigned bh_ = (unsigned)(L_) >> 5, x_ = (unsigned)(L_) & 31u, qb_ = (pass_) ? 63u - x_ : x_, b_ = bh_ >> 3, h_ = bh_ & 7u; \
            (R).qo = (bh_ * SEQ + qb_ * 256u) * 256u; (R).ko = bh_ * (SEQ * 256u); (R).vo = (R).ko; \
            (R).oo = ((b_ * SEQ + qb_ * 256u) * AW + h_ * 128u) * 2u; (R).mo = b_ * ((SEQ / 64) * SEQ * 8u); (R).P0 = (int)(qb_ * 256u); } while (0)
            att::BlockRef cur, nxt; int pass = 0; ATT_REF(cur, Lc, 0);
            att::Seam S;
            att::attn_prime(AB, cur, (char*)lds + RING_OFF, S);
            for (;;) {
                const bool more_pass = pass == 0, more_item = Lc + F.G < total, last = !more_pass && !more_item;
                int passn = pass + 1, Ln = Lc;
                if (!more_pass) { passn = 0; Ln = more_item ? Lc + F.G : Lc; }
                if (last) nxt = cur; else ATT_REF(nxt, Ln, passn);
                att::attn_block(AB, cur, nxt, SEQ, (char*)lds + RING_OFF, S);
                if (last) break;
                cur = nxt; pass = passn; Lc = Ln;
            }
#undef ATT_REF
        }

}
__device__ __forceinline__ void phase4(Frame& F, unsigned char* lds) {
    unsigned char* ws = F.ws;
        pg8::Gemm g{(const pg8::bf16_t*)(ws + WS_YA), (const pg8::bf16_t*)(ws + WS_WA), MT, DM, AW}; pg8::StaticOrder S; S.init(MT, DM, F.G, (int)blockIdx.x);
        pg8::EpiMix<false> E{(const unsigned char*)(ws + WS_GA), (pg8::bf16_t*)(ws + WS_MIXED)};
        pg8::gemm_phase<pg8::EpiMix<false>, pg8::StaticOrder, G4_ALIGN, G4_SP2>(F.lds + RING_OFF, g, S, E);

}
__device__ __forceinline__ void phase5(Frame& F, unsigned char* lds) {
    unsigned char* ws = F.ws;
        pg8::Gemm g{(const pg8::bf16_t*)(ws + WS_YB), (const pg8::bf16_t*)(ws + WS_WB), MT, DM, GW}; pg8::StaticOrder S; S.init(MT, DM, F.G, (int)blockIdx.x);
        pg8::EpiMix<true> E{(const unsigned char*)(ws + WS_GB), (pg8::bf16_t*)(ws + WS_MIXED)};
        pg8::gemm_phase<pg8::EpiMix<true>, pg8::StaticOrder, G4_ALIGN, G4_SP2>(F.lds + RING_OFF, g, S, E);

}
__device__ __forceinline__ void phase6(Frame& F, unsigned char* lds) {
    unsigned char* ws = F.ws;
        pg8::Gemm g{(const pg8::bf16_t*)(ws + WS_MIXED), (const pg8::bf16_t*)(ws + WS_WO), MT, DM, DM}; pg8::StaticOrder S; S.init(MT, DM, F.G, (int)blockIdx.x);
        pg8::EpiWo E{F.in[0], (pg8::bf16_t*)(ws + WS_X1G), (float*)(ws + WS_X1SS)};
        pg8::gemm_phase<pg8::EpiWo, pg8::StaticOrder, G4_ALIGN, G4_SP2>(F.lds + RING_OFF, g, S, E);

}
__device__ __forceinline__ void phase7(Frame& F, unsigned char* lds) {
    unsigned char* ws = F.ws;
        pg8::Gemm g{(const pg8::bf16_t*)(ws + WS_X1G), (const pg8::bf16_t*)(ws + WS_WQ), MT, DM, DM}; pg8::StaticOrder S; S.init(MT, DM, F.G, (int)blockIdx.x);
        pg8::EpiPlainBf16 E{(pg8::bf16_t*)(ws + WS_QP), DM};
        pg8::gemm_phase<pg8::EpiPlainBf16, pg8::StaticOrder, G4_ALIGN, G4_SP2>(F.lds + RING_OFF, g, S, E);

}
__device__ __forceinline__ void phase8(Frame& F, unsigned char* lds) {
    unsigned char* ws = F.ws;

        route_init(F);
        { const int NU = (MT / 64) * 8; RouteOps R;
            if (F.vcu < NU) { route_load_bk(F, F.vcu & 7, R); route_load_aq(F, F.vcu >> 3, F.vcu & 7, R); }
#pragma unroll 1
            for (int i = F.vcu; i < NU; i += F.G) { const int in = i + F.G; route_unit(F, i >> 3, i & 7, R, in < NU ? in >> 3 : -1, in & 7); } }
        __syncthreads();

}
__device__ __forceinline__ void phase9(Frame& F, unsigned char* lds, const XcdBarrier& bar) {
    if (F.G * NWAVES * 16 == MT) { peer_sweep(F, bar); return; }
    LAS float* cbuf = (LAS float*)(F.lds + RING_OFF) + F.wave * 128;
    const int gw = F.vcu * NWAVES + F.wave, NGW = F.G * NWAVES;
    for (int tok = gw; tok < MT; tok += NGW) peer_token2(F, tok, cbuf);
}
struct Args { const float* in[15]; float* out; unsigned char* ws; int ph_lo, ph_hi, li, pad; };
__global__ void __launch_bounds__(NWAVES * 64, 2) fwd_kernel(Args args) {
    extern __shared__ __attribute__((aligned(16))) unsigned char lds[];
    Frame F;
    F.lds = (LAS unsigned char*)lds;
    F.MISC = (volatile LAS unsigned*)(F.lds + MISC_OFF);
    F.tid = threadIdx.x; F.lane = F.tid & 63; F.wave = __builtin_amdgcn_readfirstlane(F.tid >> 6);
    F.G = gridDim.x; { const int bx = blockIdx.x; F.vcu = (F.G % 8 == 0) ? (bx % 8) * (F.G / 8) + bx / 8 : bx; }
    F.ws = args.ws; F.ctl = (gu32*)(args.ws + WS_CTL); F.out = args.out;
#pragma unroll
    for (int i = 0; i < 15; ++i) F.in[i] = args.in[i];
    for (int u = F.tid; u < (LDS_BYTES - LDSCTL_OFF) / 4; u += NWAVES * 64) ((LAS unsigned*)(F.lds + LDSCTL_OFF))[u] = 0u;
    __syncthreads();
    const int bli = (N_LAUNCHES == PER_PHASE) ? 0 : args.li;
    XcdBarrier bar; bar.bar = (unsigned*)(F.ctl + CW_BAR) + bli * XCD_BAR_WORDS; bar.x = 0; bar.st = nullptr;
    if (N_LAUNCHES != PER_PHASE) bar = xcd_barrier_post((unsigned*)(F.ctl + CW_BAR) + bli * XCD_BAR_WORDS, F.MISC + 8);
#define GRID_BAR(seam) do { if (N_LAUNCHES == PER_PHASE) { if (F.tid == 0) __hip_atomic_store(F.ctl + CW_TMO, 0xBADBA0u | (unsigned)(seam), RLX_AGENT); } else { xcd_barrier(bar); } } while (0)
    const int lo = args.ph_lo, hi = args.ph_hi;
#ifndef PHASE_MASK
#define PHASE_MASK 0x3ff
#endif
#define IN(k) (((PHASE_MASK >> (k)) & 1) && lo <= (k) && (k) < hi)
#define BOTH(k) (IN(k) && IN((k) + 1))
    unsigned char* ws = args.ws;

#define REP(k) ((REPEAT_MASK >> (k)) & 1)
#define RUNPH(k, call) do { if (IN(k)) { call; if (REP(k)) { GRID_BAR(k); call; } if (BOTH(k)) GRID_BAR(k); } } while (0)
    RUNPH(0, phase0(F, lds));
    RUNPH(1, phase1(F, lds, bar));
    RUNPH(2, phase2(F, lds));
    RUNPH(3, phase3(F, lds));
    do { if (IN(4)) { phase4(F, lds); if (REP(4)) { GRID_BAR(4); phase4(F, lds); } if (BOTH(4)) { asm volatile("s_waitcnt vmcnt(0)" ::: "memory"); __syncthreads(); } } } while (0);
    RUNPH(5, phase5(F, lds));
    RUNPH(6, phase6(F, lds));
    RUNPH(7, phase7(F, lds));
    RUNPH(8, phase8(F, lds));
    RUNPH(9, phase9(F, lds, bar));
#undef RUNPH
#undef IN
#undef BOTH
}

extern "C" void kernel_launch(void* const* d_in, const int* in_sizes, int n_in, void* d_out, int out_size, void* d_ws, size_t ws_size, hipStream_t stream) {
    static int grid = 0;
    if (grid == 0) {
        if (n_in != 15 || in_sizes[0] != MT * DM || out_size != MT * DM || ws_size < WS_END) {
            fprintf(stderr, "kernel_launch: built for 15 inputs, x/out of %d floats, >= %zu bytes of workspace; got n_in %d, in0 %d, out %d, ws %zu; nothing launched\n", MT * DM, (size_t)WS_END, n_in, n_in > 0 ? in_sizes[0] : -1, out_size, ws_size); grid = -1; return; }
        int dev = 0, cus = 0, per_cu = 0;
        if (hipGetDevice(&dev) != hipSuccess || hipDeviceGetAttribute(&cus, hipDeviceAttributeMultiprocessorCount, dev) != hipSuccess) { fprintf(stderr, "kernel_launch: device query failed\n"); grid = -1; return; }
        if (hipFuncSetAttribute((const void*)fwd_kernel, hipFuncAttributeMaxDynamicSharedMemorySize, LDS_BYTES) != hipSuccess) { fprintf(stderr, "kernel_launch: hipFuncSetAttribute failed\n"); grid = -1; return; }
        if (hipOccupancyMaxActiveBlocksPerMultiprocessor(&per_cu, (const void*)fwd_kernel, NWAVES * 64, LDS_BYTES) != hipSuccess || per_cu < 1)
            fprintf(stderr, "kernel_launch: note: occupancy query reports %d workgroups per CU\n", per_cu);
        (void)hipGetLastError();
        grid = cus;
    }
    if (grid < 0) return;
    if (hipMemsetAsync((char*)d_ws + WS_CTL, 0, CTL_ZERO_BYTES, stream) != hipSuccess) { fprintf(stderr, "kernel_launch: memset failed\n"); return; }
    Args a{};
    for (int i = 0; i < 15; ++i) a.in[i] = (const float*)d_in[i];
    a.out = (float*)d_out; a.ws = (unsigned char*)d_ws; a.pad = 0;
    for (int li = 0; li < N_LAUNCHES; ++li) {
        a.ph_lo = (N_LAUNCHES == PER_PHASE) ? li : 0; a.ph_hi = (N_LAUNCHES == PER_PHASE) ? li + 1 : PER_PHASE; a.li = li;
        hipLaunchKernelGGL(fwd_kernel, dim3(grid), dim3(NWAVES * 64), LDS_BYTES, stream, a);
        const hipError_t le = hipPeekAtLastError();
        if (le != hipSuccess) { fprintf(stderr, "kernel_launch: launch %d failed: %s\n", li, hipGetErrorName(le)); break; }
    }
}
```

```cpp
#include <hip/hip_runtime.h>
#include <cstdio>
#include <cstdint>
#define MK_N_LAUNCHES 1
#define GAS __attribute__((address_space(1)))
#define LAS __attribute__((address_space(3)))
namespace pg8 {
#define PG8_LAS __attribute__((address_space(3)))
typedef unsigned short bf16_t;
typedef short bf16x8 __attribute__((ext_vector_type(8)));
typedef float f32x4 __attribute__((ext_vector_type(4)));
typedef unsigned u32x4 __attribute__((ext_vector_type(4)));
constexpr int BM = 256, BK = 64, HALF = 128, HTB = HALF * BK * 2  , STAGE_BYTES = 8 * HTB, NXCD = 8, WGM = 8;

__host__ __device__ __forceinline__ int lds_byte(int r, int c) { const int st = (r >> 4) * 2 + (c >> 5), rr = r & 15, cc = c & 31, ob = rr * 64 + cc * 2; return st * 1024 + (ob ^ (((ob >> 9) & 1) << 5)); }
__host__ __device__ __forceinline__ void stage_rc(int b, int& R, int& C) { const int st = b / 1024, sb = b % 1024, swz = sb ^ (((sb >> 9) & 1) << 5); R = (st >> 1) * 16 + swz / 64; C = (st & 1) * 32 + (swz % 64) / 2; }
__host__ __device__ __forceinline__ int perm32(int rho) { const int n = rho >> 4, i = rho & 15; return 8 * (i >> 2) + 4 * n + (i & 3); }

struct Unit { int pm, pn; };
struct Gemm { const bf16_t* A; const bf16_t* Bt; int M, N, K; };

struct StaticOrder {
    int nM, nN, nwg, G, c;
    __host__ __device__ void init(int M, int N, int G_, int c_) { nM = M / BM; nN = N / BM; nwg = nM * nN; G = G_; c = c_; }
    __host__ __device__ bool next(int i, Unit& u) const {
        const long L = (long)i * G + c; if (L >= nwg) return false;
        int wgid = (int)L; { const int q = nwg / NXCD, r = nwg % NXCD, xcd = wgid % NXCD, off = wgid / NXCD; wgid = (xcd < r ? xcd * (q + 1) : r * (q + 1) + (xcd - r) * q) + off; }
        const int nig = WGM * nN, gid = wgid / nig, fm = gid * WGM, gsz = (nM - fm) < WGM ? (nM - fm) : WGM;
        u.pm = fm + ((wgid % nig) % gsz); u.pn = (wgid % nig) / gsz; return true;
    }
    __device__ __forceinline__ void a_ready(const Unit&) const {}
    __device__ __forceinline__ void done(const Unit&) const {}
};

__device__ __forceinline__ unsigned cvt_pk_bf16(float lo, float hi) { unsigned r; asm volatile("v_cvt_pk_bf16_f32 %0, %1, %2" : "=v"(r) : "v"(lo), "v"(hi)); return r; }
typedef float f32x2 __attribute__((ext_vector_type(2)));
template <class Epi, class Sched, bool ALIGN_EPI = false, bool SP2 = false, bool I8 = false>
__device__ __forceinline__ void gemm_phase(PG8_LAS unsigned char* lds, const Gemm g, const Sched& S, const Epi& E) {
    typedef int i32x4_t __attribute__((ext_vector_type(4)));
    const int tid = threadIdx.x, wid = __builtin_amdgcn_readfirstlane(tid >> 6), lane = tid & 63, wr = wid >> 2, wc = wid & 3, fr = lane & 15, fq = lane >> 4;
    const int K = g.K, nt = K / BK;
    unsigned voffA[2], voffB[2];
#pragma unroll
    for (int i = 0; i < 2; ++i) { int R, C; stage_rc(tid * 16 + i * 8192, R, C); const int Rb = Epi::PERM ? ((R & ~31) + perm32(R & 31)) : R;
        voffA[i] = (unsigned)(R * K + C) * 2u; voffB[i] = (unsigned)(Rb * K + C) * 2u; }
    const size_t kstep = (size_t)(BK * 2);
    const size_t hstep = (size_t)HALF * K * 2;
    const size_t tstep = 2 * hstep;
    const unsigned ldsw = (unsigned)wid * 1024u;
    const int aoff = lds_byte(wr * 64 + fr, fq * 8), boff = lds_byte(wc * 32 + fr, fq * 8);
#define PG8_SA(b, h) (((b) * 2 + (h)) * HTB)
#define PG8_SB(b, h) ((4 + (b) * 2 + (h)) * HTB)
#define PG8_STAGE(bufoff, gbase, voff) do { _Pragma("unroll") for (int _i = 0; _i < 2; ++_i) \
        __builtin_amdgcn_global_load_lds((const unsigned*)((const char*)(gbase) + (voff)[_i]), (PG8_LAS unsigned*)(lds + (bufoff) + ldsw + _i * 8192), 16, 0, 0); } while (0)
#define PG8_LDA(dst, b, h) do { _Pragma("unroll") for (int m = 0; m < 4; ++m) _Pragma("unroll") for (int k = 0; k < 2; ++k) dst[m][k] = *(const PG8_LAS bf16x8*)(lds + PG8_SA(b, h) + aoff + m * 2048 + k * 1024); } while (0)
#define PG8_LDB(dst, b, h) do { _Pragma("unroll") for (int n = 0; n < 2; ++n) _Pragma("unroll") for (int k = 0; k < 2; ++k) dst[n][k] = *(const PG8_LAS bf16x8*)(lds + PG8_SB(b, h) + boff + n * 2048 + k * 1024); } while (0)
#define PG8_MMA(ai, bj, At, Bt) do { __builtin_amdgcn_s_setprio(1); _Pragma("unroll") for (int m = 0; m < 4; ++m) _Pragma("unroll") for (int n = 0; n < 2; ++n) _Pragma("unroll") for (int k = 0; k < 2; ++k) \
        { if constexpr (I8) acc[ai][bj][m][n] = __builtin_bit_cast(f32x4, __builtin_amdgcn_mfma_i32_16x16x64_i8(__builtin_bit_cast(i32x4_t, Bt[n][k]), __builtin_bit_cast(i32x4_t, At[m][k]), __builtin_bit_cast(i32x4_t, acc[ai][bj][m][n]), 0, 0, 0)); \
          else acc[ai][bj][m][n] = __builtin_amdgcn_mfma_f32_16x16x32_bf16(Bt[n][k], At[m][k], acc[ai][bj][m][n], 0, 0, 0); } __builtin_amdgcn_s_setprio(0); } while (0)
#define PG8_WAIT_V(n) asm volatile("s_waitcnt vmcnt(" #n ")" ::: "memory")
#define PG8_WAIT_L(n) asm volatile("s_waitcnt lgkmcnt(" #n ")" ::: "memory")
#define PG8_BAR __builtin_amdgcn_s_barrier()
#define PG8_SCHED __builtin_amdgcn_sched_barrier(0)
    Unit cur, nxt; int ui = 0;
    if (!S.next(0, cur)) return;
    f32x4 acc[2][2][4][2];
#pragma unroll
    for (int a = 0; a < 2; ++a)
#pragma unroll
        for (int b = 0; b < 2; ++b)
#pragma unroll
            for (int m = 0; m < 4; ++m)
#pragma unroll
                for (int n = 0; n < 2; ++n) acc[a][b][m][n] = (f32x4){0.f, 0.f, 0.f, 0.f};
    bf16x8 At[4][2], B0[2][2], B1[2][2];
    const char* cA = (const char*)g.A + (size_t)cur.pm * tstep; const char* cB = (const char*)g.Bt + (size_t)cur.pn * tstep;
    S.a_ready(cur);
    if constexpr (SP2) {
        PG8_STAGE(PG8_SB(0, 0), cB, voffB); PG8_STAGE(PG8_SB(0, 1), cB + hstep, voffB); PG8_STAGE(PG8_SA(0, 0), cA, voffA); PG8_STAGE(PG8_SA(0, 1), cA + hstep, voffA);
        if (wr == 1) PG8_BAR;
        PG8_WAIT_V(2); PG8_BAR;
        PG8_STAGE(PG8_SB(1, 0), cB + kstep, voffB); PG8_STAGE(PG8_SA(1, 0), cA + kstep, voffA); PG8_STAGE(PG8_SB(1, 1), cB + hstep + kstep, voffB);
        PG8_WAIT_V(6); PG8_BAR;
    } else {
        PG8_STAGE(PG8_SB(0, 0), cB, voffB); PG8_STAGE(PG8_SA(0, 0), cA, voffA); PG8_STAGE(PG8_SB(0, 1), cB + hstep, voffB); PG8_STAGE(PG8_SA(0, 1), cA + hstep, voffA);
        if (wr == 1) PG8_BAR;
        PG8_WAIT_V(4); PG8_BAR;
        PG8_STAGE(PG8_SB(1, 0), cB + kstep, voffB); PG8_STAGE(PG8_SA(1, 0), cA + kstep, voffA); PG8_STAGE(PG8_SB(1, 1), cB + hstep + kstep, voffB);
        PG8_WAIT_V(6); PG8_BAR;
    }
    for (;;) {
        const bool has_next = S.next(ui + 1, nxt);
        const char* nA = has_next ? (const char*)g.A + (size_t)nxt.pm * tstep : cA; const char* nB = has_next ? (const char*)g.Bt + (size_t)nxt.pn * tstep : cB;
        for (int t = 0; t < nt; t += 2) {
            const bool last = (t == nt - 2);
            const char* a1 = cA + (size_t)(t + 1) * kstep;
            const char* a2 = last ? nA : cA + (size_t)(t + 2) * kstep; const char* b2 = last ? nB : cB + (size_t)(t + 2) * kstep;
            const char* a3 = a2 + kstep; const char* b3 = b2 + kstep;
            if (last && has_next) S.a_ready(nxt);
            if constexpr (SP2) {
            PG8_LDB(B0, 0, 0); PG8_LDB(B1, 0, 1); PG8_SCHED; PG8_LDA(At, 0, 0); PG8_STAGE(PG8_SA(1, 1), a1 + hstep, voffA);
            PG8_WAIT_V(8); PG8_WAIT_L(0); PG8_BAR; PG8_MMA(0, 0, At, B0); PG8_MMA(0, 1, At, B1); PG8_BAR; PG8_SCHED;
            PG8_LDA(At, 0, 1); PG8_STAGE(PG8_SB(0, 0), b2, voffB); PG8_STAGE(PG8_SB(0, 1), b2 + hstep, voffB); PG8_STAGE(PG8_SA(0, 0), a2, voffA);
            PG8_WAIT_V(8); PG8_WAIT_L(0); PG8_BAR; PG8_MMA(1, 0, At, B0); PG8_MMA(1, 1, At, B1); PG8_BAR; PG8_SCHED;
            PG8_LDB(B0, 1, 0); PG8_LDB(B1, 1, 1); PG8_SCHED; PG8_LDA(At, 1, 0); PG8_STAGE(PG8_SA(0, 1), a2 + hstep, voffA);
            PG8_WAIT_V(8); PG8_WAIT_L(0); PG8_BAR; PG8_MMA(0, 0, At, B0); PG8_MMA(0, 1, At, B1); PG8_BAR; PG8_SCHED;
            PG8_LDA(At, 1, 1); PG8_STAGE(PG8_SB(1, 0), b3, voffB); PG8_STAGE(PG8_SB(1, 1), b3 + hstep, voffB); PG8_STAGE(PG8_SA(1, 0), a3, voffA);
            PG8_WAIT_V(8); PG8_WAIT_L(0); PG8_BAR; PG8_MMA(1, 0, At, B0); PG8_MMA(1, 1, At, B1); PG8_BAR; PG8_SCHED;
            } else {
            PG8_LDB(B0, 0, 0); PG8_SCHED; PG8_LDA(At, 0, 0); PG8_STAGE(PG8_SA(1, 1), a1 + hstep, voffA);
            PG8_WAIT_L(8); PG8_BAR; PG8_WAIT_L(0); PG8_MMA(0, 0, At, B0); PG8_BAR; PG8_SCHED;
            PG8_LDB(B1, 0, 1); PG8_STAGE(PG8_SB(0, 0), b2, voffB);
            PG8_BAR; PG8_WAIT_L(0); PG8_MMA(0, 1, At, B1); PG8_BAR;
            PG8_LDA(At, 0, 1); PG8_STAGE(PG8_SA(0, 0), a2, voffA);
            PG8_BAR; PG8_WAIT_L(0); PG8_MMA(1, 0, At, B0); PG8_BAR; PG8_SCHED;
            PG8_STAGE(PG8_SB(0, 1), b2 + hstep, voffB);
            PG8_WAIT_V(6); PG8_BAR; PG8_MMA(1, 1, At, B1); PG8_BAR;
            PG8_LDB(B0, 1, 0); PG8_SCHED; PG8_LDA(At, 1, 0); PG8_STAGE(PG8_SA(0, 1), a2 + hstep, voffA);
            PG8_WAIT_L(8); PG8_BAR; PG8_WAIT_L(0); PG8_MMA(0, 0, At, B0); PG8_BAR; PG8_SCHED;
            PG8_LDB(B1, 1, 1); PG8_STAGE(PG8_SB(1, 0), b3, voffB);
            PG8_BAR; PG8_WAIT_L(0); PG8_MMA(0, 1, At, B1); PG8_BAR;
            PG8_LDA(At, 1, 1); PG8_STAGE(PG8_SA(1, 0), a3, voffA);
            PG8_BAR; PG8_WAIT_L(0); PG8_MMA(1, 0, At, B0); PG8_BAR; PG8_SCHED;
            PG8_STAGE(PG8_SB(1, 1), b3 + hstep, voffB);
            PG8_WAIT_V(6); PG8_BAR; PG8_MMA(1, 1, At, B1); PG8_BAR;
            }
        }
        if constexpr (ALIGN_EPI) { if (wr == 0) PG8_BAR; }
        if constexpr (!Epi::AFTER_DRAIN) { E(acc, cur, wr, wc, fr, fq); S.done(cur); }
        if (!has_next) break;
#pragma unroll
        for (int a = 0; a < 2; ++a)
#pragma unroll
            for (int b = 0; b < 2; ++b)
#pragma unroll
                for (int m = 0; m < 4; ++m)
#pragma unroll
                    for (int n = 0; n < 2; ++n) acc[a][b][m][n] = (f32x4){0.f, 0.f, 0.f, 0.f};
        cur = nxt; cA = nA; cB = nB; ++ui;
        if constexpr (ALIGN_EPI) { if (wr == 1) PG8_BAR; }
    }
    PG8_WAIT_V(0);
    if constexpr (!ALIGN_EPI) { if (wr == 0) PG8_BAR; }
    PG8_BAR;
    if constexpr (Epi::AFTER_DRAIN) { E.fused(acc, cur, wr, wc, fr, fq, lds, wid, lane); S.done(cur); }
#undef PG8_SA
#undef PG8_SB
#undef PG8_STAGE
#undef PG8_LDA
#undef PG8_LDB
#undef PG8_MMA
#undef PG8_WAIT_V
#undef PG8_WAIT_L
#undef PG8_BAR
#undef PG8_SCHED
}
}
#define XB_TMO      128
#define XB_XCNT(j)  (256  + 64 * (j))
#define XB_XSUB(j)  (1280 + 64 * (j))
#define XB_XGEN(j)  (2304 + 64 * (j))
#define XB_TOP      3328
#define XB_TOPGEN   3392
#define XCD_BAR_WORDS 3456
#define XB_SPIN_CAP (1u << 18)

__device__ __forceinline__ unsigned xb_ld(unsigned* p)              { return __hip_atomic_load(p, __ATOMIC_RELAXED, __HIP_MEMORY_SCOPE_AGENT); }
__device__ __forceinline__ unsigned xb_add(unsigned* p, unsigned v) { return __hip_atomic_fetch_add(p, v, __ATOMIC_RELAXED, __HIP_MEMORY_SCOPE_AGENT); }
__device__ __forceinline__ unsigned xb_xcc_id() { return (unsigned)__builtin_amdgcn_s_getreg((3 << 11) | 20) & 0xFu; }
#define XB_SPIN(cond, bar) do { unsigned _sp = 0; while (cond) { __builtin_amdgcn_s_sleep(1); \
    if ((++_sp & 255u) == 0u) { if (xb_ld(&(bar)[XB_TMO])) break; if (_sp > XB_SPIN_CAP) { atomicAdd(&(bar)[XB_TMO], 1u); break; } } } } while (0)

struct XcdBarrier {
    unsigned* bar; unsigned x;
    volatile LAS unsigned* st;
};

__device__ __forceinline__ XcdBarrier xcd_barrier_post(unsigned* bar, volatile LAS unsigned* st) {
    XcdBarrier b; b.bar = bar; b.x = xb_xcc_id(); b.st = st;
    if (threadIdx.x == 0) (void)xb_add(&bar[XB_XCNT(b.x)], 1u);
    return b;
}
__device__ __forceinline__ void xcd_barrier_complete(unsigned* bar, unsigned x, unsigned& nloc, unsigned& nx) {
    const unsigned G = gridDim.x * gridDim.y * gridDim.z;
    unsigned sum, cnt, mine, sp = 0u;
    for (;;) {
        sum = 0u; cnt = 0u; mine = 0u;
#pragma unroll
        for (unsigned j = 0; j < 16; ++j) { const unsigned c = xb_ld(&bar[XB_XCNT(j)]); sum += c; cnt += (c > 0u) ? 1u : 0u; mine = (j == x) ? c : mine; }
        if (sum == G) break;
        __builtin_amdgcn_s_sleep(1);
        if ((++sp & 255u) == 0u) { if (xb_ld(&bar[XB_TMO])) break; if (sp > XB_SPIN_CAP) { atomicAdd(&bar[XB_TMO], 1u); break; } }
    }
    nloc = mine > 0u ? mine : 1u; nx = cnt > 0u ? cnt : 1u;
}

__device__ __forceinline__ void xcd_barrier(const XcdBarrier& b) {
    asm volatile("s_waitcnt vmcnt(0)" ::: "memory");
    __syncthreads();
    if (threadIdx.x == 0) {
        unsigned* bar = b.bar;
        __builtin_amdgcn_s_waitcnt(0);
        unsigned nloc = b.st[0], nx = b.st[1];
        if (nloc == 0u) { xcd_barrier_complete(bar, b.x, nloc, nx); b.st[0] = nloc; b.st[1] = nx; }
        const unsigned old = xb_add(&bar[XB_XSUB(b.x)], 1u);
        const unsigned gen = old / nloc;
        if (old + 1u == (gen + 1u) * nloc) {
            __builtin_amdgcn_fence(__ATOMIC_RELEASE, "agent");
            asm volatile("s_waitcnt vmcnt(0)" ::: "memory");
            const unsigned og = xb_add(&bar[XB_TOP], 1u);
            const unsigned tg = og / nx;
            if (og + 1u == (tg + 1u) * nx) xb_add(&bar[XB_TOPGEN], 1u);
            else XB_SPIN(xb_ld(&bar[XB_TOPGEN]) == tg, bar);
            __builtin_amdgcn_fence(__ATOMIC_ACQUIRE, "agent");
            xb_add(&bar[XB_XGEN(b.x)], 1u);
            asm volatile("s_waitcnt vmcnt(0)" ::: "memory");
        } else {
            XB_SPIN(xb_ld(&bar[XB_XGEN(b.x)]) == gen, bar);
            __builtin_amdgcn_fence(__ATOMIC_ACQUIRE, "agent");
            asm volatile("s_waitcnt vmcnt(0)" ::: "memory");
        }
    }
    __syncthreads();
}

namespace att {
constexpr int D = 128, ODM = 1024;
constexpr float SCALE = 0.08838834764831845f;
constexpr int NW = 8, QBLK = 32, KVBLK = 64, QB = NW * QBLK;
constexpr int SHM_V = KVBLK * D * 2, SHM_K = KVBLK * D * 2;
constexpr int LDS_BYTES = 2 * SHM_V + 2 * SHM_K + NW * 64 * 4;
constexpr float THR = 8.f;
using bf16 = unsigned short;
typedef short bf16x8 __attribute__((ext_vector_type(8)));
typedef short s16x4 __attribute__((ext_vector_type(4)));
typedef float f32x16 __attribute__((ext_vector_type(16)));
typedef float f32x4 __attribute__((ext_vector_type(4)));
typedef unsigned u32x4 __attribute__((ext_vector_type(4)));

#define KSWZ(row, colB) ((row) * 256 + ((colB) ^ (((row) & 7) << 4)))
#define SBAR() __builtin_amdgcn_sched_barrier(0)
__device__ __forceinline__ int v_st(int k, int c) { const int kk = (k & ~0xC) | ((k & 4) << 1) | ((k & 8) >> 1); return ((kk >> 3) * 4 + (c >> 5)) * 512 + ((kk & 7) * 32 + (c & 31)) * 2; }
__device__ __forceinline__ int v_rd_base(int lane) { return ((lane & 3) << 3) | (((lane >> 2) & 3) << 6) | (((lane >> 4) & 1) << 5) | (((lane >> 5) & 1) << 8); }
constexpr int v_rd_off(int d0, int ks, int half) { return d0 * 512 + ks * 4096 + half * 2048; }
__device__ __forceinline__ int crow(int r, int hi) { return (r & 3) + 8 * (r >> 2) + 4 * hi; }
__device__ __forceinline__ unsigned cvtpk(float lo, float hi) { unsigned r; asm volatile("v_cvt_pk_bf16_f32 %0, %1, %2" : "=v"(r) : "v"(lo), "v"(hi)); return r; }
__device__ __forceinline__ bf16x8 load8(const bf16* p) { return *reinterpret_cast<const bf16x8*>(p); }
__device__ __forceinline__ void mask_tile(f32x16& p0, f32x16& p1, int dq, unsigned W) {
    const float NEG = -__builtin_inff();
#pragma unroll
    for (int r = 0; r < 16; ++r) {
        const int c = (r & 3) + 8 * (r >> 2);
        if ((unsigned)(dq - c) >= W) p0[r] = NEG;
        if ((unsigned)(dq - c - 32) >= W) p1[r] = NEG;
    }
}
__device__ __forceinline__ float bitand_f(float v, int m) { return __uint_as_float(__float_as_uint(v) & (unsigned)m); }
__device__ __forceinline__ void partialSM(f32x16& p0, f32x16& p1, float& m_reg, float& mn, float& alpha, unsigned mw) {
    float pmax = p0[0]; for (int r = 1; r < 16; ++r) pmax = fmaxf(pmax, p0[r]); for (int r = 0; r < 16; ++r) pmax = fmaxf(pmax, p1[r]);
    { auto rr = __builtin_amdgcn_permlane32_swap(__float_as_uint(pmax), __float_as_uint(pmax), false, false);
      pmax = fmaxf(__uint_as_float(rr[0]), __uint_as_float(rr[1])); }
    constexpr float C2 = 1.4426950408889634f * SCALE;
    if (__builtin_expect(__all((pmax - m_reg) * SCALE <= THR), 1)) { mn = m_reg; alpha = 1.f; }
    else { mn = fmaxf(m_reg, pmax); alpha = __builtin_amdgcn_exp2f((m_reg - mn) * C2); m_reg = mn; }
    const float mnL = -mn * C2;
    for (int r = 0; r < 16; ++r) p0[r] = fmaf(p0[r], C2, mnL); for (int r = 0; r < 16; ++r) p1[r] = fmaf(p1[r], C2, mnL);
    unsigned ms = mw << 16;
#pragma unroll
    for (int r = 15; r >= 0; --r) { float e = __builtin_amdgcn_exp2f(p0[r]); asm volatile("v_add_co_u32 %0, vcc, %0, %0\n\tv_cndmask_b32 %1, 0, %1, vcc" : "+v"(ms), "+v"(e) : : "vcc"); p0[r] = e; }
}
__device__ __forceinline__ void finishSM(f32x16& p0, f32x16& p1, float alpha, float& l_reg, bf16x8& pa0, bf16x8& pa1, bf16x8& pa2, bf16x8& pa3, unsigned mw) {
    unsigned ms = mw;
#pragma unroll
    for (int r = 15; r >= 0; --r) { float e = __builtin_amdgcn_exp2f(p1[r]); asm volatile("v_add_co_u32 %0, vcc, %0, %0\n\tv_cndmask_b32 %1, 0, %1, vcc" : "+v"(ms), "+v"(e) : : "vcc"); p1[r] = e; }
    float ps = 0; for (int r = 0; r < 16; ++r) ps += p0[r]; for (int r = 0; r < 16; ++r) ps += p1[r];
    { auto rr = __builtin_amdgcn_permlane32_swap(__float_as_uint(ps), __float_as_uint(ps), false, false);
      ps = __uint_as_float(rr[0]) + __uint_as_float(rr[1]); }
    l_reg = l_reg * alpha + ps;
#define PK4(P, B_, OUT) do { unsigned a0 = cvtpk(P[B_+0], P[B_+1]), a1 = cvtpk(P[B_+2], P[B_+3]);                          \
        unsigned b0 = cvtpk(P[B_+4], P[B_+5]), b1 = cvtpk(P[B_+6], P[B_+7]);                                             \
        auto r0 = __builtin_amdgcn_permlane32_swap(a0, b0, false, false); auto r1 = __builtin_amdgcn_permlane32_swap(a1, b1, false, false); \
        u32x4 w = {r0[0], r1[0], r0[1], r1[1]}; OUT = *reinterpret_cast<bf16x8*>(&w); } while (0)
    PK4(p0, 0, pa0); PK4(p0, 8, pa1); PK4(p1, 0, pa2); PK4(p1, 8, pa3);
#undef PK4
}
template <int KB>
__device__ __forceinline__ void qkt(f32x16& p0, f32x16& p1, const char* K_lds, int r32, int hi, const bf16x8* qr) {
    p0 = f32x16{}; p1 = f32x16{};
    const char* kb[4];
#pragma unroll
    for (int dd = 0; dd < 4; ++dd) kb[dd] = K_lds + KB * SHM_K + KSWZ(r32, (dd * 16 + hi * 8) * 2);
#pragma unroll
    for (int d0 = 0; d0 < 8; ++d0) { const char* a = kb[d0 & 3] + (d0 >> 2) * 128;
        bf16x8 b0 = *reinterpret_cast<const bf16x8*>(a);
        bf16x8 b1 = *reinterpret_cast<const bf16x8*>(a + 32 * 256);
        p0 = __builtin_amdgcn_mfma_f32_32x32x16_bf16(b0, qr[d0], p0, 0, 0, 0);
        p1 = __builtin_amdgcn_mfma_f32_32x32x16_bf16(b1, qr[d0], p1, 0, 0, 0); }
}
template <int VB>
__device__ __forceinline__ void pv_tile(f32x16* o, int vb0, bf16x8 pa0, bf16x8 pa1, bf16x8 pa2, bf16x8 pa3) {
#define TRRD(dst, off) asm volatile("ds_read_b64_tr_b16 %0, %1 offset:%2" : "=&v"(dst) : "v"(vb0), "i"(off) : "memory")
#define PV_D0(d0) do { s16x4 l0, l1, l2, l3, h0, h1, h2, h3; constexpr int b_ = VB * SHM_V + v_rd_off(d0, 0, 0); \
        TRRD(l0, b_); TRRD(h0, b_ + 2048); TRRD(l1, b_ + 4096); TRRD(h1, b_ + 6144); TRRD(l2, b_ + 8192); TRRD(h2, b_ + 10240); TRRD(l3, b_ + 12288); TRRD(h3, b_ + 14336); \
        asm volatile("s_waitcnt lgkmcnt(0)" ::: "memory"); SBAR();   \
        o[d0] = __builtin_amdgcn_mfma_f32_32x32x16_bf16(pa0, (bf16x8){l0[0], l0[1], l0[2], l0[3], h0[0], h0[1], h0[2], h0[3]}, o[d0], 0, 0, 0);   \
        o[d0] = __builtin_amdgcn_mfma_f32_32x32x16_bf16(pa1, (bf16x8){l1[0], l1[1], l1[2], l1[3], h1[0], h1[1], h1[2], h1[3]}, o[d0], 0, 0, 0);   \
        o[d0] = __builtin_amdgcn_mfma_f32_32x32x16_bf16(pa2, (bf16x8){l2[0], l2[1], l2[2], l2[3], h2[0], h2[1], h2[2], h2[3]}, o[d0], 0, 0, 0);   \
        o[d0] = __builtin_amdgcn_mfma_f32_32x32x16_bf16(pa3, (bf16x8){l3[0], l3[1], l3[2], l3[3], h3[0], h3[1], h3[2], h3[3]}, o[d0], 0, 0, 0); } while (0)
    PV_D0(0); PV_D0(1); PV_D0(2); PV_D0(3);
#undef PV_D0
#undef TRRD
}

struct BlockRef { unsigned qo, ko, vo, oo, mo; int P0; };
struct Bufs { __amdgpu_buffer_rsrc_t q, k, v, o, m; };
__device__ __forceinline__ bf16x8 bld8(__amdgpu_buffer_rsrc_t r, int voff, int soff) { return __builtin_bit_cast(bf16x8, __builtin_amdgcn_raw_buffer_load_b128(r, voff, soff, 0)); }
struct Seam { bf16x8 qr[8]; bf16x8 st_v0, st_v1, st_k0, st_k1; };
#define VMW() asm volatile("s_waitcnt vmcnt(0)" ::: "memory")
#define VMWN(n) asm volatile("s_waitcnt vmcnt(%0)" :: "i"(n) : "memory")
#define SLOAD_H(R, k0) do { S.st_v0 = bld8(B.v, vkv, (R).vo + (k0) * 256); S.st_v1 = bld8(B.v, vkv, (R).vo + ((k0) + 32) * 256);              \
                         S.st_k0 = bld8(B.k, vkv, (R).ko + (k0) * 256); S.st_k1 = bld8(B.k, vkv, (R).ko + ((k0) + 32) * 256); } while (0)
#define SWRITE_HK(bf) do { *(bf16x8*)(K_lds + (bf) * SHM_K + kws) = S.st_k0; *(bf16x8*)(K_lds + (bf) * SHM_K + kws + 32 * 256) = S.st_k1; } while (0)
#define SWRITE_HV(bf) do { *(bf16x8*)(V_lds + (bf) * SHM_V + vst0) = S.st_v0; *(bf16x8*)(V_lds + (bf) * SHM_V + vst1) = S.st_v1; } while (0)
#define SWRITE_H(bf) do { SWRITE_HV(bf); SWRITE_HK(bf); } while (0)
__device__ __forceinline__ void attn_prime(const Bufs& B, const BlockRef& cur, char* lds, Seam& S) {
    const int tid = threadIdx.x, wid = __builtin_amdgcn_readfirstlane(tid >> 6), lane = tid & 63, r32 = lane & 31, hi = lane >> 5;
    const int sr = tid >> 4, sc = (tid & 15) * 8, kws = KSWZ(sr, sc * 2); char* K_lds = lds + 2 * SHM_V;
    const int vkv = sr * 256 + sc * 2, vq = ((wid * QBLK + r32) * D + hi * 8) * 2;
    for (int d0 = 0; d0 < 8; ++d0) S.qr[d0] = bld8(B.q, vq + d0 * 32, cur.qo);
    SLOAD_H(cur, 0); VMW(); SWRITE_HK(0);
    __syncthreads();
}
__device__ __forceinline__ void attn_block(const Bufs& B, const BlockRef& cur, const BlockRef& nxt, int S_len, char* lds, Seam& S) {
    const int tid = threadIdx.x, wid = __builtin_amdgcn_readfirstlane(tid >> 6), lane = tid & 63, r32 = lane & 31, hi = lane >> 5;
    const int W = 1 << 30;
    const int j_lo = 0;
    const int j_hi = (cur.P0 + QB - 1) / KVBLK + 1;
    const int NT = j_hi - j_lo;
    const int kbn = 0;
    const int qlo = cur.P0 + wid * QBLK, qm = qlo + r32 - 4 * hi;
    char* V_lds = lds; char* K_lds = lds + 2 * SHM_V;
    float* ws = (float*)(lds + 2 * SHM_V + 2 * SHM_K) + wid * 64; float* li_l = ws, * al_l = ws + 32;
    float m_reg = -1e30f, l_reg = 0; f32x16 o[4] = {};
    const int sr = tid >> 4, sc = (tid & 15) * 8, vst0 = v_st(sr, sc), vst1 = v_st(32 + sr, sc), kws = KSWZ(sr, sc * 2);
    const int vb0 = (int)(uintptr_t)V_lds + v_rd_base(lane);
    const int vkv = sr * 256 + sc * 2, vq = ((wid * QBLK + r32) * D + hi * 8) * 2;
    const int vm = ((qlo + r32) * 2 + hi) * 4; const int mws = S_len * 8;
#define MLOAD(t) __builtin_amdgcn_raw_buffer_load_b32(B.m, vm, cur.mo + (t) * mws, 0)
#define RESC(a) do { if (__any((a) < 1.f)) { if (hi == 0) al_l[r32] = (a); asm volatile("s_waitcnt lgkmcnt(0)" ::: "memory");              \
                     for (int d_ = 0; d_ < 4; ++d_) for (int r = 0; r < 16; ++r) o[d_][r] *= al_l[crow(r, hi)]; } } while (0)
#define KBASE(t) ((j_lo + (t)) * KVBLK)
#define MASKT(P0_, P1_, t) do { const int kb_ = KBASE(t); if (kb_ + KVBLK - 1 > qlo) mask_tile(P0_, P1_, qm - kb_, (unsigned)W); } while (0)
    constexpr int NQL = 8;
#define SEAM_K0() do { VMWN(NQL); SWRITE_HK(0); SBAR(); } while (0)
    f32x16 pA0, pA1, pB0, pB1; float mnA, mnB, alA, alB; bf16x8 pa0, pa1, pa2, pa3; unsigned mwA, mwB;
    SWRITE_HV(0); SBAR();
    mwA = MLOAD(0);
    if (NT > 1) { SLOAD_H(cur, KBASE(1)); }
    SBAR(); qkt<0>(pA0, pA1, K_lds, r32, hi, S.qr);
    MASKT(pA0, pA1, 0); partialSM(pA0, pA1, m_reg, mnA, alA, mwA);
    if (NT > 1) { VMW(); SWRITE_H(1); }
    __syncthreads();
#define ATT_PIPE(nl, nv) do { _Pragma("unroll") for (int i_ = 0; i_ < 16; ++i_) { __builtin_amdgcn_sched_group_barrier(0x008, 1, 0); __builtin_amdgcn_sched_group_barrier(0x100, nl, 0); __builtin_amdgcn_sched_group_barrier(0x002, nv, 0); } } while (0)
#define HALF_STEP(PX0, PX1, mnX, alX, mwX, PY0, PY1, alY, mwY, t, KB, VB, SB) do {                                            \
        mwX = MLOAD(t);                                                                                         \
        SBAR(); qkt<KB>(PX0, PX1, K_lds, r32, hi, S.qr);                                                                      \
        finishSM(PY0, PY1, alY, l_reg, pa0, pa1, pa2, pa3, mwY); SBAR();                                                      \
        if ((t) + 1 < NT) { SLOAD_H(cur, KBASE((t) + 1)); SBAR(); }                                                        \
        MASKT(PX0, PX1, (t)); pv_tile<VB>(o, vb0, pa0, pa1, pa2, pa3); partialSM(PX0, PX1, m_reg, mnX, alX, mwX); ATT_PIPE(2, 9);  \
        __syncthreads();                                                                                                      \
        if ((t) + 1 < NT) { VMW(); SWRITE_H(SB); }                                                                            \
        RESC(alX); __syncthreads(); } while (0)
    for (int t = 1; t + 1 < NT; t += 2) {
        HALF_STEP(pB0, pB1, mnB, alB, mwB, pA0, pA1, alA, mwA, t, 1, 0, 0);
        HALF_STEP(pA0, pA1, mnA, alA, mwA, pB0, pB1, alB, mwB, t + 1, 0, 1, 1);
    }
    const bool even = (NT & 1) == 0;
    if (even) { mwB = MLOAD(NT - 1); SBAR(); qkt<1>(pB0, pB1, K_lds, r32, hi, S.qr); SBAR(); }
    SLOAD_H(nxt, kbn); SBAR();
#pragma unroll
    for (int d0 = 0; d0 < 8; ++d0) S.qr[d0] = bld8(B.q, vq + d0 * 32, nxt.qo);
    SBAR();
    finishSM(pA0, pA1, alA, l_reg, pa0, pa1, pa2, pa3, mwA); SBAR();
    pv_tile<0>(o, vb0, pa0, pa1, pa2, pa3);
    if (even) { MASKT(pB0, pB1, NT - 1); partialSM(pB0, pB1, m_reg, mnB, alB, mwB); __syncthreads(); RESC(alB);
        finishSM(pB0, pB1, alB, l_reg, pa0, pa1, pa2, pa3, mwB); SBAR(); pv_tile<1>(o, vb0, pa0, pa1, pa2, pa3); }
    SBAR(); SEAM_K0();
    if (hi == 0) li_l[r32] = l_reg; asm volatile("s_waitcnt lgkmcnt(0)" ::: "memory");
    float rli[16];
#pragma unroll
    for (int r = 0; r < 16; ++r) rli[r] = __builtin_amdgcn_rcpf(li_l[crow(r, hi)]);
    const int vo_l = ((wid * QBLK + 4 * hi) * ODM + r32) * 2;
#pragma unroll
    for (int r = 0; r < 16; ++r) {
#pragma unroll
        for (int d0 = 0; d0 < 4; ++d0) { const float v = o[d0][r] * rli[r];
            const float vn = __shfl_xor(v, 1);
            if ((r32 & 1) == 0) __builtin_amdgcn_raw_buffer_store_b32(cvtpk(v, vn), B.o, vo_l, cur.oo + (((r & 3) + 8 * (r >> 2)) * ODM + d0 * 32) * 2, 0); } }
    __syncthreads();
#undef RESC
#undef KBASE
#undef MASKT
#undef SEAM_K0
#undef HALF_STEP
#undef MLOAD
}
#undef ROW
#undef VMW
#undef VMWN
#undef SLOAD_H
#undef SWRITE_HK
#undef SWRITE_HV
#undef SWRITE_H
#undef KSWZ
#undef SBAR
}
constexpr int BATCH = 2, SEQ = 16384, DM = 2048, MT = BATCH * SEQ;
constexpr int AH = 8, AW = 1024, GW = 1024, NINP = 9984, NIN = 9800;
constexpr int NEXP = 16384;
constexpr int NI8 = 36 * 256;
constexpr float EPS = 1e-6f;
constexpr int NWAVES = 8;
constexpr int N_LAUNCHES = MK_N_LAUNCHES;
constexpr int PER_PHASE = 10;
constexpr size_t MiB = 1u << 20;
constexpr size_t WS_CTL = 0, CTL_ZERO_BYTES = 1 * MiB;
constexpr size_t WS_WIN = 2 * MiB, WS_WA = 41 * MiB, WS_WB = 45 * MiB, WS_WO = 49 * MiB, WS_WQ = 57 * MiB, WS_SUBK = 65 * MiB, WS_PU = 66 * MiB  , WS_PV = 98 * MiB  , WS_SU = 130 * MiB, WS_SV = 130 * MiB + 65536;
constexpr size_t WS_WIN8 = 131 * MiB  , WS_SW = 152 * MiB  , WS_SX = 153 * MiB  , WS_XN8 = 937 * MiB  ;
constexpr size_t WS_XN = 194 * MiB, WS_YA = 194 * MiB, WS_YB = 258 * MiB, WS_X1G = 194 * MiB;
constexpr size_t WS_Q = 322 * MiB, WS_K = 386 * MiB, WS_V = 450 * MiB, WS_MIXED = 322 * MiB;
constexpr size_t WS_QI = 514 * MiB, WS_KI = 546 * MiB, WS_WI = 550 * MiB;
constexpr size_t WS_GU = 551 * MiB, WS_GV = 615 * MiB, WS_GA = 679 * MiB, WS_GB = 807 * MiB;
constexpr size_t WS_GVSS = 935 * MiB, WS_MASK = 937 * MiB, WS_X1SS = 1001 * MiB;
constexpr size_t WS_QP = 450 * MiB, WS_EIDX = 578 * MiB, WS_EGATE = 594 * MiB;
constexpr size_t WS_END = 1005 * MiB;
constexpr int CW_TMO = 0, CW_BAR = 4096;

constexpr int RING_OFF = 0, RING_BYTES = 131072;
constexpr int LDSCTL_OFF = RING_BYTES, MISC_OFF = LDSCTL_OFF + 320;
constexpr int LDS_BYTES = 147456;

typedef unsigned short bf16;
typedef unsigned v4u __attribute__((ext_vector_type(4)));
typedef unsigned v2u __attribute__((ext_vector_type(2)));
typedef float f32x4 __attribute__((ext_vector_type(4)));
typedef float f32x16 __attribute__((ext_vector_type(16)));
typedef short bf16x8 __attribute__((ext_vector_type(8)));
typedef __bf16 bf2_t __attribute__((ext_vector_type(2)));
typedef __bf16 bf8_t __attribute__((ext_vector_type(8)));
typedef GAS unsigned gu32;
#define RLX_AGENT __ATOMIC_RELAXED, __HIP_MEMORY_SCOPE_AGENT
#define LDS_WAIT() asm volatile("s_waitcnt lgkmcnt(0)" ::: "memory")
#define VM_WAIT() asm volatile("s_waitcnt vmcnt(0)" ::: "memory")
__device__ __forceinline__ unsigned f2bf(float f) { unsigned u = __builtin_bit_cast(unsigned, f); return (u + 0x7fffu + ((u >> 16) & 1u)) >> 16; }
__device__ __forceinline__ unsigned pk2(float lo, float hi) { return pg8::cvt_pk_bf16(lo, hi); }
__device__ __forceinline__ float bflo(unsigned w) { return __uint_as_float(w << 16); }
__device__ __forceinline__ float bfhi(unsigned w) { return __uint_as_float(w & 0xffff0000u); }
__device__ __forceinline__ float wave_sum(float v) {
#pragma unroll
    for (int o = 1; o < 64; o <<= 1) v += __shfl_xor(v, o);
    return v;
}
__device__ __forceinline__ float gelu_t(float x) {
    const float y2 = x * (1.5957691216f + 0.0713548162726f * x * x);
    const float e = __builtin_amdgcn_exp2f(-1.4426950409f * y2);
    return x * __builtin_amdgcn_rcpf(1.f + e);
}
__device__ __forceinline__ float ub0(unsigned u) { return (float)(u & 255u); }
__device__ __forceinline__ float ub1(unsigned u) { return (float)((u >> 8) & 255u); }
__device__ __forceinline__ float ub2(unsigned u) { return (float)((u >> 16) & 255u); }
__device__ __forceinline__ float ub3(unsigned u) { return (float)(u >> 24); }
__device__ __forceinline__ float sigmoid_f(float x) { return __builtin_amdgcn_rcpf(1.f + __builtin_amdgcn_exp2f(-1.4426950409f * x)); }
__device__ __forceinline__ unsigned sortable(float v) { const unsigned u = __float_as_uint(v + 0.0f); return u ^ ((unsigned)((int)u >> 31) | 0x80000000u); }
__device__ __forceinline__ int crow(int r, int hi) { return (r & 3) + 8 * (r >> 2) + 4 * hi; }
__device__ __forceinline__ unsigned ckey(unsigned sk) { const int ds = (int)(sk ^ 0x80000000u); constexpr int ZK = 190 << 22;
    const int cl = ds < -ZK ? -ZK : (ds > ZK ? ZK : ds); return (unsigned)(ds - cl) ^ 0x80000000u; }

struct Frame {
    LAS unsigned char* lds;
    volatile LAS unsigned* MISC;
    gu32* ctl;
    int tid, lane, wave;
    int vcu, G;
    unsigned char* ws;
    const float* in[15];
    float* out;
};

namespace pg8 {
template <bool I8> struct EpiInProj {
    static constexpr bool PERM = true, AFTER_DRAIN = false;
    unsigned char* ws; int pn_off;
#define IPV(ai, bj, m, n) (I8 ? __builtin_convertvector(__builtin_bit_cast(i32x4_t, acc[ai][bj][m][n]), f32x4) * (swv[bj][n] * sxr[ai][m]) : acc[ai][bj][m][n])
    typedef int i32x4_t __attribute__((ext_vector_type(4)));
    __device__ __forceinline__ void operator()(const f32x4 (&acc)[2][2][4][2], const Unit& u, int wr, int wc, int fr, int fq) const {
        const int pn = u.pn + pn_off, row0 = u.pm * BM + wr * 64 + fr, cw = wc * 32 + 8 * fq;
        f32x4 swv[2][2]; float sxr[2][4];
        if (I8) { const float* sw = (const float*)(ws + WS_SW) + pn * BM + cw; const float* sx = (const float*)(ws + WS_SX) + row0;
#pragma unroll
            for (int bj = 0; bj < 2; ++bj)
#pragma unroll
                for (int n = 0; n < 2; ++n) swv[bj][n] = *(const f32x4*)(sw + bj * HALF + 4 * n);
#pragma unroll
            for (int ai = 0; ai < 2; ++ai)
#pragma unroll
                for (int m = 0; m < 4; ++m) sxr[ai][m] = sx[ai * HALF + m * 16]; }
        if (pn < 12) {
            bf16_t* base = (bf16_t*)(ws + WS_Q + (size_t)(pn >> 2) * (64 * MiB));
#pragma unroll
            for (int ai = 0; ai < 2; ++ai)
#pragma unroll
                for (int m = 0; m < 4; ++m) { const int row = row0 + ai * HALF + m * 16, b = row >> 14, s = row & (SEQ - 1);
#pragma unroll
                    for (int bj = 0; bj < 2; ++bj) { const int head = (pn & 3) * 2 + bj; const f32x4 v0 = IPV(ai, bj, m, 0), v1 = IPV(ai, bj, m, 1);
                        u32x4 w; w.x = cvt_pk_bf16(v0[0], v0[1]); w.y = cvt_pk_bf16(v0[2], v0[3]); w.z = cvt_pk_bf16(v1[0], v1[1]); w.w = cvt_pk_bf16(v1[2], v1[3]);
                        *(u32x4*)(base + ((size_t)(b * AH + head) * SEQ + s) * 128 + cw) = w; } }
        } else if (pn == 38) {
#pragma unroll
            for (int ai = 0; ai < 2; ++ai)
#pragma unroll
                for (int m = 0; m < 4; ++m) { const int row = row0 + ai * HALF + m * 16; const f32x4 v0 = IPV(ai, 0, m, 0), v1 = IPV(ai, 0, m, 1);
                    if (wc < 2) { u32x4 w; w.x = cvt_pk_bf16(v0[0], v0[1]); w.y = cvt_pk_bf16(v0[2], v0[3]); w.z = cvt_pk_bf16(v1[0], v1[1]); w.w = cvt_pk_bf16(v1[2], v1[3]);
                        *(u32x4*)((bf16_t*)(ws + WS_KI) + (size_t)row * 64 + cw) = w; }
                    else if (wc == 2 && fq == 0) { float* wp = (float*)(ws + WS_WI) + (size_t)row * 8; const float sc = 0.35355339059327373f;
                        *(f32x4*)wp = v0 * sc; *(f32x4*)(wp + 4) = v1 * sc; } }
        } else {
            bf16_t* base; int ldc, colt; int mode = 0;
            if (pn >= 36) { base = (bf16_t*)(ws + WS_QI); ldc = 512; colt = (pn - 36) * 256; }
            else if (pn < 16) { base = (bf16_t*)(ws + WS_GU); ldc = 1024; colt = (pn - 12) * 256; mode = 1; }
            else if (pn < 20) { base = (bf16_t*)(ws + WS_GV); ldc = 1024; colt = (pn - 16) * 256; mode = 2; }
            else {
                unsigned char* g8 = ws + (pn < 28 ? WS_GA : WS_GB) + (pn < 28 ? pn - 20 : pn - 28) * 256 + cw;
#pragma unroll
                for (int ai = 0; ai < 2; ++ai)
#pragma unroll
                    for (int m = 0; m < 4; ++m) { const int row = row0 + ai * HALF + m * 16;
#pragma unroll
                        for (int bj = 0; bj < 2; ++bj) { const f32x4 v0 = IPV(ai, bj, m, 0), v1 = IPV(ai, bj, m, 1); v2u w; w.x = 0u; w.y = 0u;
#pragma unroll
                            for (int j = 0; j < 4; ++j) { w.x = __builtin_amdgcn_cvt_pk_u8_f32(255.f * sigmoid_f(v0[j]), j, w.x); w.y = __builtin_amdgcn_cvt_pk_u8_f32(255.f * sigmoid_f(v1[j]), j, w.y); }
                            *(v2u*)(g8 + (size_t)row * 2048 + bj * HALF) = w; } }
                return; }
#pragma unroll
            for (int ai = 0; ai < 2; ++ai)
#pragma unroll
                for (int m = 0; m < 4; ++m) { const int row = row0 + ai * HALF + m * 16; bf16_t* rowp = base + (size_t)row * ldc + colt + cw; float ss = 0.f;
#pragma unroll
                    for (int bj = 0; bj < 2; ++bj) { f32x4 v0 = IPV(ai, bj, m, 0), v1 = IPV(ai, bj, m, 1);
                        if (mode) {
#pragma unroll
                            for (int j = 0; j < 4; ++j) { v0[j] = gelu_t(v0[j]); v1[j] = gelu_t(v1[j]); ss += v0[j] * v0[j] + v1[j] * v1[j]; } }
                        u32x4 w; w.x = cvt_pk_bf16(v0[0], v0[1]); w.y = cvt_pk_bf16(v0[2], v0[3]); w.z = cvt_pk_bf16(v1[0], v1[1]); w.w = cvt_pk_bf16(v1[2], v1[3]);
                        *(u32x4*)(rowp + bj * HALF) = w; }
                    if (mode == 2) { ss += __shfl_xor(ss, 16); ss += __shfl_xor(ss, 32);
                        if (fq == 0) ((float*)(ws + WS_GVSS))[(size_t)row * 16 + (pn - 16) * 4 + wc] = ss; } }
        }
    }
};
#undef IPV
template <bool ACCUM> struct EpiMix {
    static constexpr bool PERM = true, AFTER_DRAIN = false;
    const unsigned char* gate; bf16_t* mixed;
    __device__ __forceinline__ void operator()(const f32x4 (&acc)[2][2][4][2], const Unit& u, int wr, int wc, int fr, int fq) const {
        const int row0 = u.pm * BM + wr * 64 + fr, col0 = u.pn * BM + wc * 32 + 8 * fq;
#pragma unroll
        for (int ai = 0; ai < 2; ++ai) {
            v2u gq[4][2]; u32x4 pq[4][2];
#pragma unroll
            for (int m = 0; m < 4; ++m) { const size_t off = (size_t)(row0 + ai * HALF + m * 16) * DM + col0;
#pragma unroll
                for (int bj = 0; bj < 2; ++bj) { gq[m][bj] = *(const v2u*)(gate + off + bj * HALF); if (ACCUM) pq[m][bj] = *(const u32x4*)(mixed + off + bj * HALF); } }
#pragma unroll
            for (int m = 0; m < 4; ++m) { const size_t off = (size_t)(row0 + ai * HALF + m * 16) * DM + col0;
#pragma unroll
                for (int bj = 0; bj < 2; ++bj) { const v2u g = gq[m][bj]; const f32x4 a0 = acc[ai][bj][m][0] * (1.f / 255.f), a1 = acc[ai][bj][m][1] * (1.f / 255.f);
                    float o[8];
                    o[0] = a0[0] * ub0(g.x); o[1] = a0[1] * ub1(g.x); o[2] = a0[2] * ub2(g.x); o[3] = a0[3] * ub3(g.x);
                    o[4] = a1[0] * ub0(g.y); o[5] = a1[1] * ub1(g.y); o[6] = a1[2] * ub2(g.y); o[7] = a1[3] * ub3(g.y);
                    if (ACCUM) { const u32x4 p = pq[m][bj];
                        o[0] += bflo(p.x); o[1] += bfhi(p.x); o[2] += bflo(p.y); o[3] += bfhi(p.y); o[4] += bflo(p.z); o[5] += bfhi(p.z); o[6] += bflo(p.w); o[7] += bfhi(p.w); }
                    u32x4 w; w.x = cvt_pk_bf16(o[0], o[1]); w.y = cvt_pk_bf16(o[2], o[3]); w.z = cvt_pk_bf16(o[4], o[5]); w.w = cvt_pk_bf16(o[6], o[7]);
                    *(u32x4*)(mixed + off + bj * HALF) = w; } } }
    }
};
struct EpiWo {
    static constexpr bool PERM = true, AFTER_DRAIN = false;
    const float* x; bf16_t* x1; float* ss_out;
    __device__ __forceinline__ void operator()(const f32x4 (&acc)[2][2][4][2], const Unit& u, int wr, int wc, int fr, int fq) const {
        const int row0 = u.pm * BM + wr * 64 + fr, col0 = u.pn * BM + wc * 32 + 8 * fq;
#pragma unroll
        for (int ai = 0; ai < 2; ++ai) {
            f32x4 xq[4][2][2];
#pragma unroll
            for (int m = 0; m < 4; ++m) { const size_t off = (size_t)(row0 + ai * HALF + m * 16) * DM + col0;
#pragma unroll
                for (int bj = 0; bj < 2; ++bj) { xq[m][bj][0] = *(const f32x4*)(x + off + bj * HALF); xq[m][bj][1] = *(const f32x4*)(x + off + bj * HALF + 4); } }
#pragma unroll
            for (int m = 0; m < 4; ++m) { const int row = row0 + ai * HALF + m * 16; const size_t off = (size_t)row * DM + col0; float ss = 0.f;
#pragma unroll
                for (int bj = 0; bj < 2; ++bj) { const f32x4 o0 = xq[m][bj][0] + acc[ai][bj][m][0], o1 = xq[m][bj][1] + acc[ai][bj][m][1];
                    ss += ((o0[0] * o0[0] + o0[1] * o0[1]) + (o0[2] * o0[2] + o0[3] * o0[3])) + ((o1[0] * o1[0] + o1[1] * o1[1]) + (o1[2] * o1[2] + o1[3] * o1[3]));
                    u32x4 w; w.x = cvt_pk_bf16(o0[0], o0[1]); w.y = cvt_pk_bf16(o0[2], o0[3]); w.z = cvt_pk_bf16(o1[0], o1[1]); w.w = cvt_pk_bf16(o1[2], o1[3]);
                    *(u32x4*)(x1 + off + bj * HALF) = w; }
                ss += __shfl_xor(ss, 16); ss += __shfl_xor(ss, 32);
                if (fq == 0) ss_out[(size_t)row * 32 + u.pn * 4 + wc] = ss; } }
    }
};
struct EpiPlainBf16 {
    static constexpr bool PERM = true, AFTER_DRAIN = false;
    bf16_t* O; int ldc;
    __device__ __forceinline__ void operator()(const f32x4 (&acc)[2][2][4][2], const Unit& u, int wr, int wc, int fr, int fq) const {
        const int row0 = u.pm * BM + wr * 64 + fr, col0 = u.pn * BM + wc * 32 + 8 * fq;
#pragma unroll
        for (int ai = 0; ai < 2; ++ai)
#pragma unroll
            for (int m = 0; m < 4; ++m) { bf16_t* rowp = O + (size_t)(row0 + ai * HALF + m * 16) * ldc + col0;
#pragma unroll
                for (int bj = 0; bj < 2; ++bj) { const f32x4 v0 = acc[ai][bj][m][0], v1 = acc[ai][bj][m][1];
                    u32x4 w; w.x = cvt_pk_bf16(v0[0], v0[1]); w.y = cvt_pk_bf16(v0[2], v0[3]); w.z = cvt_pk_bf16(v1[0], v1[1]); w.w = cvt_pk_bf16(v1[2], v1[3]);
                    *(u32x4*)(rowp + bj * HALF) = w; } }
    }
};
}

template <bool WIN>
__device__ __forceinline__ void p0_transpose_item(const float* W, int K, int Nsrc, int Ndst, bf16* WT, LAS float* scr, int item, int lane, const float* ksc = nullptr) {
    const int nblk = Ndst / 32, kb = item / nblk, nb = item % nblk, k0 = 64 * kb, n0 = 32 * nb;
    int src = n0 + (lane & 31);
    if (WIN) { if (src >= 9800) src = -1; else if (src >= 9216) src -= 6144; else if (src >= 3072) src += 584; }
    float tv[32];
#pragma unroll
    for (int i = 0; i < 32; ++i) { const int kk = 2 * i + (lane >> 5); tv[i] = src >= 0 ? W[(size_t)(k0 + kk) * Nsrc + src] : 0.f; }
#pragma unroll
    for (int i = 0; i < 32; ++i) { const int kk = 2 * i + (lane >> 5); scr[kk * 33 + (lane & 31)] = ksc ? tv[i] * ksc[k0 + kk] : tv[i]; }
    LDS_WAIT(); asm volatile("" ::: "memory");
    const int c = lane & 7;
#pragma unroll
    for (int j = 0; j < 4; ++j) { const int n = (lane >> 3) + 8 * j; const LAS float* s = scr + (8 * c) * 33 + n;
        v4u o; o.x = pk2(s[0 * 33], s[1 * 33]); o.y = pk2(s[2 * 33], s[3 * 33]); o.z = pk2(s[4 * 33], s[5 * 33]); o.w = pk2(s[6 * 33], s[7 * 33]);
        *(GAS v4u*)(WT + (size_t)(n0 + n) * K + k0 + 8 * c) = o; }
    LDS_WAIT(); asm volatile("" ::: "memory");
}
__device__ __forceinline__ void p0_convert(const float* src, bf16* dst, size_t n, size_t gtid, size_t gthreads) {
    for (size_t i = gtid * 8; i < n; i += gthreads * 8) { const f32x4 a = *(const GAS f32x4*)(src + i), b = *(const GAS f32x4*)(src + i + 4);
        v4u o; o.x = pk2(a[0], a[1]); o.y = pk2(a[2], a[3]); o.z = pk2(b[0], b[1]); o.w = pk2(b[2], b[3]); *(GAS v4u*)(dst + i) = o; }
}
__device__ __forceinline__ float wave_max(float v) {
#pragma unroll
    for (int o = 1; o < 64; o <<= 1) v = fmaxf(v, __shfl_xor(v, o));
    return v;
}
__device__ __forceinline__ int wave_sum_i(int v) {
#pragma unroll
    for (int o = 1; o < 64; o <<= 1) v += __shfl_xor(v, o);
    return v;
}
__device__ __forceinline__ unsigned pack_q8(float a, float b, float c, float d, float inv, int off) {
    const int qa = (int)__builtin_rintf(a * inv) + off, qb = (int)__builtin_rintf(b * inv) + off, qc = (int)__builtin_rintf(c * inv) + off, qd = (int)__builtin_rintf(d * inv) + off;
    return (unsigned)(qa & 255) | ((unsigned)(qb & 255) << 8) | ((unsigned)(qc & 255) << 16) | ((unsigned)(qd & 255) << 24);
}
constexpr float PEER_CLIP = 0.75f;
__device__ __forceinline__ unsigned pack_q4x8(const float* x, float inv, int off) {
    unsigned w = 0u;
#pragma unroll
    for (int i = 0; i < 8; ++i) { float q = __builtin_rintf(x[i] * inv); q = fminf(fmaxf(q, -7.f), 7.f); const unsigned n = (unsigned)((int)q + off) & 15u; w |= n << (8 * (i >> 1) + 4 * (i & 1)); }
    return w;
}
__device__ __forceinline__ void p0_quant_row(const float* src, unsigned char* dst, float* scale_out, int lane, int off, unsigned xr) {
    const float* r = src + 32 * lane; float x[32]; float am = 0.f;
#pragma unroll
    for (int q = 0; q < 8; ++q) { const f32x4 v = *(const GAS f32x4*)(r + 4 * q); x[4 * q] = v.x; x[4 * q + 1] = v.y; x[4 * q + 2] = v.z; x[4 * q + 3] = v.w;
        am = fmaxf(am, fmaxf(fmaxf(__builtin_fabsf(v.x), __builtin_fabsf(v.y)), fmaxf(__builtin_fabsf(v.z), __builtin_fabsf(v.w)))); }
    am = wave_max(am); const float sc = PEER_CLIP * am * (1.f / 7.f), inv = am > 0.f ? 1.f / sc : 0.f;
    v4u o; o.x = pack_q4x8(x, inv, off); o.y = pack_q4x8(x + 8, inv, off); o.z = pack_q4x8(x + 16, inv, off); o.w = pack_q4x8(x + 24, inv, off);
    o.x ^= xr; o.y ^= xr; o.z ^= xr; o.w ^= xr;
    *(GAS v4u*)(dst + 16 * lane) = o;
    if (lane == 0) *scale_out = sc;
}
__device__ __forceinline__ void p0_prologue(Frame& F) {
    LAS float* scr = (LAS float*)(F.lds + RING_OFF + F.wave * 16384);
    const int gw = F.vcu * NWAVES + F.wave, NGW = F.G * NWAVES;
    constexpr int I_IN = (DM / 64) * (NINP / 32), I_A = (AW / 64) * (DM / 32), I_O = (DM / 64) * (DM / 32);
    constexpr int NITEMS = I_IN + 2 * I_A + 2 * I_O;
    unsigned char* ws = F.ws;
    for (int it = gw; it < NITEMS; it += NGW) {
        int r = it;
        if (r < I_IN) { p0_transpose_item<true>(F.in[2], DM, NIN, NINP, (bf16*)(ws + WS_WIN), scr, r, F.lane); continue; } r -= I_IN;
        if (r < I_A) { p0_transpose_item<false>(F.in[6], AW, DM, DM, (bf16*)(ws + WS_WA), scr, r, F.lane); continue; } r -= I_A;
        if (r < I_A) { p0_transpose_item<false>(F.in[7], GW, DM, DM, (bf16*)(ws + WS_WB), scr, r, F.lane); continue; } r -= I_A;
        if (r < I_O) { p0_transpose_item<false>(F.in[8], DM, DM, DM, (bf16*)(ws + WS_WO), scr, r, F.lane); continue; } r -= I_O;
        p0_transpose_item<false>(F.in[10], DM, DM, DM, (bf16*)(ws + WS_WQ), scr, r, F.lane, F.in[9]);
    }
    const size_t gtid = (size_t)F.vcu * (NWAVES * 64) + F.tid, gthreads = (size_t)F.G * NWAVES * 64;
    p0_convert(F.in[11], (bf16*)(ws + WS_SUBK), (size_t)8 * 2 * 128 * 128, gtid, gthreads);
    for (int r = gw; r < 2 * NEXP; r += NGW) {
        const bool isv = r >= NEXP; const int e = isv ? r - NEXP : r;
        p0_quant_row((isv ? F.in[13] : F.in[12]) + (size_t)e * DM, ws + (isv ? WS_PV : WS_PU) + (size_t)e * (DM / 2), (float*)(ws + (isv ? WS_SV : WS_SU)) + e, F.lane, isv ? 8 : 0, isv ? 0x80808080u : 0u); }
    const float* gm = F.in[1];
    for (int m = gw; m < MT; m += NGW) {
        const GAS f32x4* xr = (const GAS f32x4*)(F.in[0] + (size_t)m * DM) + F.lane;
        f32x4 v[8]; float s = 0.f;
#pragma unroll
        for (int j = 0; j < 8; ++j) { v[j] = xr[64 * j]; s += (v[j].x * v[j].x + v[j].y * v[j].y) + (v[j].z * v[j].z + v[j].w * v[j].w); }
        const float rstd = 1.f / sqrtf(wave_sum(s) * (1.f / DM) + EPS); float am = 0.f;
#pragma unroll
        for (int j = 0; j < 8; ++j) { const f32x4 gg = *((const GAS f32x4*)gm + F.lane + 64 * j); v[j] = v[j] * gg * rstd;
            am = fmaxf(am, fmaxf(fmaxf(__builtin_fabsf(v[j].x), __builtin_fabsf(v[j].y)), fmaxf(__builtin_fabsf(v[j].z), __builtin_fabsf(v[j].w)))); }
        { GAS v2u* o8 = (GAS v2u*)((bf16*)(ws + WS_XN) + (size_t)m * DM) + F.lane;
#pragma unroll
            for (int j = 0; j < 8; ++j) { v2u o; o.x = pk2(v[j].x, v[j].y); o.y = pk2(v[j].z, v[j].w); o8[64 * j] = o; } }
        am = wave_max(am); const float inv = am > 0.f ? 127.f / am : 0.f;
        GAS unsigned* o4 = (GAS unsigned*)(ws + WS_XN8 + (size_t)m * DM) + F.lane;
#pragma unroll
        for (int j = 0; j < 8; ++j) o4[64 * j] = pack_q8(v[j].x, v[j].y, v[j].z, v[j].w, inv, 0);
        if (F.lane == 0) ((float*)(ws + WS_SX))[m] = am * (1.f / 127.f);
    }
}

__device__ __forceinline__ void quant_win_rows(Frame& F) {
    unsigned char* ws = F.ws; const int gw = F.vcu * NWAVES + F.wave, NGW = F.G * NWAVES, lane = F.lane;
    for (int n = gw; n < NI8; n += NGW) { const bf16* r = (const bf16*)(ws + WS_WIN) + (size_t)n * DM + 32 * lane; float x[32]; float am = 0.f;
#pragma unroll
        for (int q = 0; q < 4; ++q) { const v4u v = *(const GAS v4u*)(r + 8 * q); const unsigned wv[4] = {v.x, v.y, v.z, v.w};
#pragma unroll
            for (int w = 0; w < 4; ++w) { x[8 * q + 2 * w] = bflo(wv[w]); x[8 * q + 2 * w + 1] = bfhi(wv[w]); am = fmaxf(am, fmaxf(__builtin_fabsf(x[8 * q + 2 * w]), __builtin_fabsf(x[8 * q + 2 * w + 1]))); } }
        am = wave_max(am); const float inv = am > 0.f ? 127.f / am : 0.f;
        v4u o0, o1;
        o0.x = pack_q8(x[0], x[1], x[2], x[3], inv, 0); o0.y = pack_q8(x[4], x[5], x[6], x[7], inv, 0); o0.z = pack_q8(x[8], x[9], x[10], x[11], inv, 0); o0.w = pack_q8(x[12], x[13], x[14], x[15], inv, 0);
        o1.x = pack_q8(x[16], x[17], x[18], x[19], inv, 0); o1.y = pack_q8(x[20], x[21], x[22], x[23], inv, 0); o1.z = pack_q8(x[24], x[25], x[26], x[27], inv, 0); o1.w = pack_q8(x[28], x[29], x[30], x[31], inv, 0);
        GAS v4u* dst = (GAS v4u*)(ws + WS_WIN8 + (size_t)n * DM + 32 * lane); dst[0] = o0; dst[1] = o1;
        if (lane == 0) ((float*)(ws + WS_SW))[n] = am * (1.f / 127.f); }
}

__device__ __forceinline__ void gmlp_unit(Frame& F, int chunk, int g) {
    constexpr int RS = 272;
    LAS unsigned char* AP = F.lds, * GT = F.lds + 128 * RS; LAS float* rs = (LAS float*)(F.lds + 2 * 128 * RS);
    const int tid = F.tid, lane = F.lane, wid = F.wave, r32 = lane & 31, hi = lane >> 5;
    const int tok0 = chunk * 128; unsigned char* ws = F.ws;
    const int ct = wid & 3;
    const float* gn = F.in[3]; const float* bsp = F.in[5]; const bf16* gup = (const bf16*)(ws + WS_GU); bf16* ybp = (bf16*)(ws + WS_YB);
    f32x4 sq[4]; if (tid < 128) { const f32x4* p = (const f32x4*)((const float*)(ws + WS_GVSS) + (size_t)(tok0 + tid) * 16); sq[0] = p[0]; sq[1] = p[1]; sq[2] = p[2]; sq[3] = p[3]; }
    f32x4 wq[4][2]; { const int t = tid >> 2, s0 = (tid & 3) * 32; const float* w = F.in[4] + ((size_t)g * 128 + t) * 128 + s0;
#pragma unroll
        for (int j = 0; j < 4; ++j) { wq[j][0] = *(const f32x4*)(w + 8 * j); wq[j][1] = *(const f32x4*)(w + 8 * j + 4); } }
    v4u gq[4]; { const bf16* gvp = (const bf16*)(ws + WS_GV);
#pragma unroll
        for (int i = 0; i < 4; ++i) { const int s = (tid >> 4) + 32 * i, c0 = (tid & 15) * 8; gq[i] = *(const v4u*)(gvp + (size_t)(tok0 + s) * GW + g * 128 + c0); } }
    v2u uq[2][4]; f32x4 gg[4]; float bias[2];
#pragma unroll
    for (int q = 0; q < 4; ++q) gg[q] = *(const f32x4*)(gn + g * 128 + 32 * ct + 8 * q + 4 * hi);
#pragma unroll
    for (int t2 = 0; t2 < 2; ++t2) { const int t = 32 * (2 * (wid >> 2) + t2) + r32; bias[t2] = bsp[g * 128 + t];
#pragma unroll
        for (int q = 0; q < 4; ++q) uq[t2][q] = *(const v2u*)(gup + ((size_t)tok0 + t) * GW + g * 128 + 32 * ct + 8 * q + 4 * hi); }
    if (tid < 128) { const f32x4 a = sq[0], b = sq[1], c = sq[2], d = sq[3];
        const float s = ((a.x + a.y) + (a.z + a.w)) + ((b.x + b.y) + (b.z + b.w)) + ((c.x + c.y) + (c.z + c.w)) + ((d.x + d.y) + (d.z + d.w));
        rs[tid] = 1.f / sqrtf(s * (1.f / GW) + EPS); }
    __syncthreads();
    { const int t = tid >> 2, s0 = (tid & 3) * 32;
#pragma unroll
        for (int j = 0; j < 4; ++j) { const f32x4 a = wq[j][0], b = wq[j][1]; float v[8] = {a.x, a.y, a.z, a.w, b.x, b.y, b.z, b.w};
#pragma unroll
            for (int e = 0; e < 8; ++e) { const int s = s0 + 8 * j + e; v[e] = (s <= t) ? v[e] * rs[s] : 0.f; }
            v4u o; o.x = pk2(v[0], v[1]); o.y = pk2(v[2], v[3]); o.z = pk2(v[4], v[5]); o.w = pk2(v[6], v[7]);
            *(LAS v4u*)(AP + t * RS + (s0 + 8 * j) * 2) = o; } }
    {
#pragma unroll
        for (int i = 0; i < 4; ++i) { const int s = (tid >> 4) + 32 * i, c0 = (tid & 15) * 8;
            const unsigned wv[4] = {gq[i].x, gq[i].y, gq[i].z, gq[i].w};
#pragma unroll
            for (int e = 0; e < 8; ++e) *(LAS unsigned short*)(GT + (c0 + e) * RS + s * 2) = (unsigned short)((e & 1) ? (wv[e >> 1] >> 16) : (wv[e >> 1] & 0xffffu)); } }
    __syncthreads();
#pragma unroll
    for (int t2 = 0; t2 < 2; ++t2) { const int tt = 2 * (wid >> 2) + t2; f32x16 acc = {};
#pragma unroll
        for (int ks = 0; ks < 8; ++ks) { const bf16x8 a = *(const LAS bf16x8*)(GT + (32 * ct + r32) * RS + (16 * ks + 8 * hi) * 2), b = *(const LAS bf16x8*)(AP + (32 * tt + r32) * RS + (16 * ks + 8 * hi) * 2);
            acc = __builtin_amdgcn_mfma_f32_32x32x16_bf16(a, b, acc, 0, 0, 0); }
        const int t = 32 * tt + r32; const size_t token = (size_t)tok0 + t;
#pragma unroll
        for (int q = 0; q < 4; ++q) { const int col = g * 128 + 32 * ct + 8 * q + 4 * hi; const v2u uu = uq[t2][q];
            const float y0 = bflo(uu.x) * (acc[4 * q + 0] * gg[q].x + bias[t2]), y1 = bfhi(uu.x) * (acc[4 * q + 1] * gg[q].y + bias[t2]), y2 = bflo(uu.y) * (acc[4 * q + 2] * gg[q].z + bias[t2]), y3 = bfhi(uu.y) * (acc[4 * q + 3] * gg[q].w + bias[t2]);
            v2u o; o.x = pk2(y0, y1); o.y = pk2(y2, y3); *(v2u*)(ybp + token * GW + col) = o; } }
    __syncthreads();
}

constexpr int IX_QL = 0, IX_QROW = 144, IX_HIST = 9 * 32 * IX_QROW  , IX_HROW = 513, IX_MROW = 257, IX_CAND = IX_HIST + 65792, IX_CAP = 64;
constexpr int IX_CCNT = IX_CAND + 32 * IX_CAP * 8, IX_PSTAR = IX_CCNT + 128, IX_NEED = IX_PSTAR + 128, IX_LOF = IX_NEED + 128, IX_FSH = IX_LOF + 128, IX_ABOVE = IX_FSH + 128, IX_FAIL = IX_ABOVE + 128, IX_VLO = IX_FAIL + 16, IX_VHI = IX_VLO + 128, IX_END = IX_VHI + 128;
constexpr int IX_GCAP = 1024;
static_assert(IX_END <= RING_BYTES, "indexer LDS");
#ifndef IX_SAMPLE_MIN
#define IX_SAMPLE_MIN 64
#endif
enum { IXM_SAMPLE = 0, IXM_FULL = 1, IXM_FINE = 2, IXM_EMIT = 3, IXM_CAND = 4 };
__device__ __forceinline__ int ix_cbin(unsigned ck) { const int b = (int)(ck >> 20) - 1536; return b < 0 ? 0 : (b > 1023 ? 1023 : b); }
__device__ __forceinline__ float ix_edge(int cb) {
    if (cb <= 0) return -__builtin_inff(); if (cb > 1023) return __builtin_inff();
    constexpr int ZK = 190 << 22; const int db = (int)(((unsigned)(cb + 1536) << 20) ^ 0x80000000u);
    const int ds = db > 0 ? db + ZK : (db == 0 ? -ZK : db - ZK); const unsigned sk = (unsigned)ds ^ 0x80000000u;
    return __uint_as_float((sk & 0x80000000u) ? (sk ^ 0x80000000u) : ~sk);
}
__device__ __forceinline__ void ix_scan_row(const LAS unsigned* hrow, int K, int lane, int& bstar, int& above, int& total, int& bcnt) {
    unsigned w[8]; int c = 0;
#pragma unroll
    for (int i = 0; i < 8; ++i) { w[i] = hrow[8 * lane + i]; c += (int)(w[i] & 0xffffu) + (int)(w[i] >> 16); }
    int s = c;
#pragma unroll
    for (int off = 1; off < 64; off <<= 1) { const int o = __shfl_down(s, off); if (lane + off < 64) s += o; }
    total = __shfl(s, 0);
    const unsigned long long m = __ballot(s >= K); const int L = m ? 63 - __builtin_clzll(m) : 0;
    int cum = s - c, bs = -1, abv = 0, bc = 0;
#pragma unroll
    for (int i = 7; i >= 0; --i) { const int h1 = (int)(w[i] >> 16), h0 = (int)(w[i] & 0xffffu);
        if (bs < 0) { if (cum + h1 >= K) { bs = 16 * lane + 2 * i + 1; abv = cum; bc = h1; } else cum += h1; }
        if (bs < 0) { if (cum + h0 >= K) { bs = 16 * lane + 2 * i; abv = cum; bc = h0; } else cum += h0; } }
    bstar = __shfl(bs, L); above = __shfl(abv, L); bcnt = __shfl(bc, L);
}
__device__ __forceinline__ void idx_unit(Frame& F, int b, int qb) {
    LAS unsigned char* L = F.lds; unsigned char* ws = F.ws;
    const int tid = F.tid, lane = F.lane, wid = F.wave, r32 = lane & 31, hi = lane >> 5;
    const int t0 = qb * 32; const size_t tokb = (size_t)b * SEQ;
    const bf16* QI = (const bf16*)(ws + WS_QI); const bf16* KI = (const bf16*)(ws + WS_KI); const float* WI = (const float*)(ws + WS_WI);
    LAS unsigned* hist = (LAS unsigned*)(L + IX_HIST); LAS unsigned* ccnt = (LAS unsigned*)(L + IX_CCNT);
    LAS int* pstar_l = (LAS int*)(L + IX_PSTAR); LAS int* need_l = (LAS int*)(L + IX_NEED); LAS int* lof_l = (LAS int*)(L + IX_LOF); LAS int* fsh_l = (LAS int*)(L + IX_FSH);
    LAS unsigned* above_l = (LAS unsigned*)(L + IX_ABOVE); LAS unsigned* fail_l = (LAS unsigned*)(L + IX_FAIL); LAS float* vlo_l = (LAS float*)(L + IX_VLO); LAS float* vhi_l = (LAS float*)(L + IX_VHI);
    unsigned* glist = (unsigned*)(ws + WS_XN) + (size_t)blockIdx.x * (32 * IX_GCAP * 2);
    { const int q = tid >> 4, h = (tid & 15) >> 1, dh = tid & 1; const float w = 0.5f * WI[(tokb + t0 + q) * 8 + h];
        const bf16* src = QI + (tokb + t0 + q) * 512 + h * 64 + dh * 32;
#pragma unroll
        for (int j = 0; j < 4; ++j) { const v4u v = *(const v4u*)(src + 8 * j);
            v4u o; o.x = pk2(bflo(v.x) * w, bfhi(v.x) * w); o.y = pk2(bflo(v.y) * w, bfhi(v.y) * w); o.z = pk2(bflo(v.z) * w, bfhi(v.z) * w); o.w = pk2(bflo(v.w) * w, bfhi(v.w) * w);
            *(LAS v4u*)(L + IX_QL + (h * 32 + q) * IX_QROW + (dh * 32 + 8 * j) * 2) = o; } }
    { const int q = tid >> 4, d4 = (tid & 15) * 4; float a0 = 0.f, a1 = 0.f, a2 = 0.f, a3 = 0.f;
#pragma unroll
        for (int h = 0; h < 8; ++h) { const float w = 0.5f * WI[(tokb + t0 + q) * 8 + h]; const v2u v = *(const v2u*)(QI + (tokb + t0 + q) * 512 + h * 64 + d4);
            a0 += w * bflo(v.x); a1 += w * bfhi(v.x); a2 += w * bflo(v.y); a3 += w * bfhi(v.y); }
        v2u o; o.x = pk2(a0, a1); o.y = pk2(a2, a3); *(LAS v2u*)(L + IX_QL + (8 * 32 + q) * IX_QROW + d4 * 2) = o; }
    unsigned sgm = 0u;
#pragma unroll
    for (int h = 0; h < 8; ++h) sgm |= (WI[(tokb + t0 + r32) * 8 + h] < 0.f ? 1u : 0u) << h;
    unsigned vmask = 0u;
#pragma unroll
    for (int r = 0; r < 16; ++r) vmask |= (crow(r, hi) <= r32 ? 1u : 0u) << r;
    const __amdgpu_buffer_rsrc_t rsG = __builtin_amdgcn_make_buffer_rsrc((void*)glist, 0, 32 * IX_GCAP * 8, 0x00020000);
    if (tid == 0) fail_l[0] = 0u;
    __syncthreads();
    const int ntile = qb + 1, ntile_e = (ntile + 1) & ~1;
    int mode = ntile >= IX_SAMPLE_MIN ? IXM_SAMPLE : IXM_FULL; bool sampled = mode == IXM_SAMPLE, cand_done = false; (void)sampled;
#pragma unroll 1
    for (;;) {
        mode = __builtin_amdgcn_readfirstlane(mode);
        if (mode <= IXM_FINE) { for (int i = tid; i < 32 * IX_HROW; i += NWAVES * 64) hist[i] = 0u; }
        if (tid < 32) { above_l[tid] = 0u; ccnt[tid] = 0u; }
        __syncthreads();
        const int lofq = lof_l[r32], fshq = fsh_l[r32], psq = pstar_l[r32];
        const float vloq = vlo_l[r32], vhiq = vhi_l[r32];
        const int jstep = mode == IXM_SAMPLE ? 8 * NWAVES : NWAVES, jend = mode >= IXM_EMIT ? ntile_e : ntile;
        bf16x8 kf[4], kn[4];
        if (wid < ntile) { const bf16* kp = KI + (tokb + 32 * wid + r32) * 64 + 8 * hi;
#pragma unroll
            for (int ks = 0; ks < 4; ++ks) kn[ks] = *(const bf16x8*)(kp + 16 * ks); }
#pragma unroll 1
        for (int j = wid; j < jend; j += jstep) {
            LAS unsigned short* mrow = (LAS unsigned short*)(hist + (r32 * 2 + hi) * IX_MROW);
            if (j >= ntile) { mrow[j] = 0; continue; }
#pragma unroll
            for (int ks = 0; ks < 4; ++ks) kf[ks] = kn[ks];
            if (j + jstep < ntile) { const bf16* kp = KI + (tokb + 32 * (j + jstep) + r32) * 64 + 8 * hi;
#pragma unroll
                for (int ks = 0; ks < 4; ++ks) kn[ks] = *(const bf16x8*)(kp + 16 * ks); }
            f32x16 sc = {};
            {
                const LAS unsigned char* qbase = L + IX_QL + r32 * IX_QROW + 16 * hi;
#define IX_QLD(dst, h_) do { _Pragma("unroll") for (int ks = 0; ks < 4; ++ks) dst[ks] = *(const LAS bf16x8*)(qbase + (h_) * 32 * IX_QROW + 32 * ks); } while (0)
#define IX_HEAD(qc, h_) do { f32x16 a = {}; _Pragma("unroll") for (int ks = 0; ks < 4; ++ks) a = __builtin_amdgcn_mfma_f32_32x32x16_bf16(kf[ks], qc[ks], a, 0, 0, 0); \
                    if ((h_) < 8) { const float sgf_ = __uint_as_float(0x3f800000u | (((sgm >> ((h_) & 7)) & 1u) << 31)); _Pragma("unroll") for (int r = 0; r < 16; ++r) sc[r] = __builtin_fmaf(__builtin_fabsf(a[r]), sgf_, sc[r]); } \
                    else { _Pragma("unroll") for (int r = 0; r < 16; ++r) sc[r] += a[r]; } \
                    asm volatile("" : "+v"(sc[0]), "+v"(sc[1]), "+v"(sc[2]), "+v"(sc[3]), "+v"(sc[4]), "+v"(sc[5]), "+v"(sc[6]), "+v"(sc[7]), "+v"(sc[8]), "+v"(sc[9]), "+v"(sc[10]), "+v"(sc[11]), "+v"(sc[12]), "+v"(sc[13]), "+v"(sc[14]), "+v"(sc[15])); } while (0)
                bf16x8 qa[4], qb[4];
                IX_QLD(qa, 8);
                IX_QLD(qb, 0); __builtin_amdgcn_sched_barrier(0);
#pragma unroll
                for (int ks = 0; ks < 4; ++ks) sc = __builtin_amdgcn_mfma_f32_32x32x16_bf16(kf[ks], qa[ks], sc, 0, 0, 0);
                __builtin_amdgcn_sched_barrier(0);
                IX_QLD(qa, 1); __builtin_amdgcn_sched_barrier(0); IX_HEAD(qb, 0); __builtin_amdgcn_sched_barrier(0);
                IX_QLD(qb, 2); __builtin_amdgcn_sched_barrier(0); IX_HEAD(qa, 1); __builtin_amdgcn_sched_barrier(0);
                IX_QLD(qa, 3); __builtin_amdgcn_sched_barrier(0); IX_HEAD(qb, 2); __builtin_amdgcn_sched_barrier(0);
                IX_QLD(qb, 4); __builtin_amdgcn_sched_barrier(0); IX_HEAD(qa, 3); __builtin_amdgcn_sched_barrier(0);
                IX_QLD(qa, 5); __builtin_amdgcn_sched_barrier(0); IX_HEAD(qb, 4); __builtin_amdgcn_sched_barrier(0);
                IX_QLD(qb, 6); __builtin_amdgcn_sched_barrier(0); IX_HEAD(qa, 5); __builtin_amdgcn_sched_barrier(0);
                IX_QLD(qa, 7); __builtin_amdgcn_sched_barrier(0); IX_HEAD(qb, 6); __builtin_amdgcn_sched_barrier(0);
                IX_HEAD(qa, 7);
#undef IX_QLD
#undef IX_HEAD
            }
            const bool diag = (j == qb); unsigned bits = 0u;
            LAS unsigned* hrow = hist + r32 * IX_HROW;
            if (mode <= IXM_FULL) {
#pragma unroll
                for (int r = 0; r < 16; ++r) { const bool valid = !diag || (crow(r, hi) <= r32); const unsigned bin = (unsigned)ix_cbin(ckey(sortable(sc[r])));
                    __hip_atomic_fetch_add(hrow + (bin >> 1), valid ? 1u << ((bin & 1u) * 16) : 0u, __ATOMIC_RELAXED, __HIP_MEMORY_SCOPE_WORKGROUP); } }
            else if (mode == IXM_FINE) {
#pragma unroll
                for (int r = 0; r < 16; ++r) { const bool valid = !diag || (crow(r, hi) <= r32); const int d = (int)(ckey(sortable(sc[r])) >> fshq) - lofq; const int dc = d < 1024 ? d : 1024;
                    __hip_atomic_fetch_add(hrow + ((dc >> 1) & 1023), (valid && d >= 0) ? 1u << ((dc & 1) * 16) : 0u, __ATOMIC_RELAXED, __HIP_MEMORY_SCOPE_WORKGROUP); } }
            else if (mode == IXM_CAND) {
                unsigned cge = 0u;
#pragma unroll
                for (int r = 15; r >= 0; --r) asm volatile("v_cmp_ge_f32 vcc, %[v], %[vh]\n\tv_addc_co_u32 %[b], vcc, %[b], %[b], vcc\n\tv_cmp_ge_f32 vcc, %[v], %[vl]\n\tv_addc_co_u32 %[c], vcc, %[c], %[c], vcc"
                    : [b] "+v"(bits), [c] "+v"(cge) : [v] "v"(sc[r]), [vh] "v"(vhiq), [vl] "v"(vloq) : "vcc");
                if (diag) { bits &= vmask; cge &= vmask; }
                const unsigned cb = cge & ~bits;
                if (bits) __hip_atomic_fetch_add(above_l + r32, (unsigned)__builtin_popcount(bits), __ATOMIC_RELAXED, __HIP_MEMORY_SCOPE_WORKGROUP);
                if (__any(cb != 0u)) { const unsigned pc = (unsigned)__builtin_popcount(cb); unsigned base = 0u;
                    if (cb) base = __hip_atomic_fetch_add(ccnt + r32, pc, __ATOMIC_RELAXED, __HIP_MEMORY_SCOPE_WORKGROUP);
                    const unsigned cbx = (base + pc <= (unsigned)IX_GCAP) ? cb : 0u;
                    const unsigned yb = ((unsigned)j << 5) | ((unsigned)hi << 4), qoff = (unsigned)r32 * (IX_GCAP * 8) + base * 8u;
#pragma unroll
                    for (int r = 0; r < 16; ++r) { const unsigned off = ((cbx >> r) & 1u) ? qoff + 8u * (unsigned)__builtin_popcount(cbx & ((1u << r) - 1u)) : 0x7ffffff0u;
                        v2u en; en.x = __float_as_uint(sc[r]); en.y = yb | (unsigned)r;
                        __builtin_amdgcn_raw_buffer_store_b64(en, rsG, off, 0, 0); } } }
            else {
#pragma unroll
                for (int r = 0; r < 16; ++r) { const int kr = crow(r, hi); const bool valid = !diag || (kr <= r32); const unsigned sk = sortable(sc[r]); const int pf = (int)(ckey(sk) >> fshq);
                    bits |= (valid && pf > psq) ? 1u << r : 0u;
                    const bool cand = valid && pf == psq;
                    if (__any(cand)) { if (cand) { const unsigned slot = __hip_atomic_fetch_add(ccnt + r32, 1u, __ATOMIC_RELAXED, __HIP_MEMORY_SCOPE_WORKGROUP);
                            if (slot < (unsigned)IX_CAP) { LAS unsigned* cd = (LAS unsigned*)(L + IX_CAND) + (r32 * IX_CAP + slot) * 2; cd[0] = sk; cd[1] = (unsigned)(32 * j + kr); } } } } }
            if (mode >= IXM_EMIT) mrow[j] = (unsigned short)bits;
        }
        __syncthreads();
        if (mode == IXM_EMIT) break;
        if (mode == IXM_CAND) {
            asm volatile("s_waitcnt vmcnt(0)" ::: "memory"); __syncthreads();
#define IX_RLOAD(raw, q_) do { const int n_ = (int)ccnt[q_]; _Pragma("unroll") for (int i = 0; i < IX_GCAP / 64; ++i) { const int e_ = i * 64 + lane; \
                raw[i] = __builtin_amdgcn_raw_buffer_load_b64(rsG, (e_ < n_ && n_ <= IX_GCAP) ? (unsigned)(((q_) * IX_GCAP + e_) * 8) : 0x7ffffff0u, 0, 0); } } while (0)
            v2u rawc[IX_GCAP / 64]; IX_RLOAD(rawc, wid * 4);
#pragma unroll 1
            for (int qq = 0; qq < 4; ++qq) { const int q = wid * 4 + qq; const int n = (int)ccnt[q], need = 256 - (int)above_l[q];
                v2u rawn[IX_GCAP / 64]; { const int qn = qq + 1 < 4 ? q + 1 : q; IX_RLOAD(rawn, qn); }
                unsigned sk[IX_GCAP / 64], ix[IX_GCAP / 64]; const int nr = (n + 63) >> 6;
#pragma unroll
                for (int i = 0; i < IX_GCAP / 64; ++i) { const bool vd = i * 64 + lane < n; const v2u en = rawc[i]; rawc[i] = rawn[i];
                    sk[i] = vd ? sortable(__uint_as_float(en.x)) : 0u; ix[i] = vd ? (en.y >> 5) * 32u + (unsigned)crow((int)(en.y & 15u), (int)((en.y >> 4) & 1u)) : 0u; }
                if (n > IX_GCAP || need < 1 || need > n) { if (lane == 0) fail_l[0] = 1u; continue; }
                unsigned pre = 0u; int bit0 = 31;
                { unsigned kor = 0u, kand = 0xffffffffu;
#pragma unroll
                    for (int i = 0; i < IX_GCAP / 64; ++i) if (i < nr) { const bool vd = i * 64 + lane < n; kor |= vd ? sk[i] : 0u; kand &= vd ? sk[i] : 0xffffffffu; }
#pragma unroll
                    for (int o = 1; o < 64; o <<= 1) { kor |= (unsigned)__shfl_xor((int)kor, o); kand &= (unsigned)__shfl_xor((int)kand, o); }
                    const unsigned df = kor ^ kand; bit0 = df ? 31 - __builtin_clz(df) : -1; pre = bit0 >= 31 ? 0u : (kand & ~((2u << bit0) - 1u)); if (bit0 < 0) pre = kand; }
#pragma unroll 1
                for (int bit = bit0; bit >= 0; --bit) { const unsigned cd_ = pre | (1u << bit); int cnt = 0;
#pragma unroll
                    for (int i = 0; i < IX_GCAP / 64; ++i) if (i < nr) cnt += __builtin_popcountll(__ballot(sk[i] >= cd_));
                    if (cnt >= need) pre = cd_; }
                int cgt = 0;
#pragma unroll
                for (int i = 0; i < IX_GCAP / 64; ++i) if (i < nr) cgt += __builtin_popcountll(__ballot(sk[i] > pre));
                const int neq = need - cgt; unsigned px = 0u;
                int ceq = 0;
#pragma unroll
                for (int i = 0; i < IX_GCAP / 64; ++i) if (i < nr) ceq += __builtin_popcountll(__ballot(sk[i] == pre && sk[i] != 0u));
                if (ceq == neq) px = 0x3fffu;
                else
#pragma unroll 1
                for (int bit = 13; bit >= 0; --bit) { const unsigned cd_ = px | (1u << bit); int cnt = 0;
#pragma unroll
                    for (int i = 0; i < IX_GCAP / 64; ++i) if (i < nr) cnt += __builtin_popcountll(__ballot(sk[i] == pre && ix[i] < cd_));
                    if (cnt < neq) px = cd_; }
#pragma unroll
                for (int i = 0; i < IX_GCAP / 64; ++i) if (i < nr) { if (sk[i] > pre || (sk[i] == pre && sk[i] != 0u && ix[i] <= px)) { const unsigned mk = ix[i];
                        const int j_ = (int)(mk >> 5), wi = (int)(mk & 31u), h2 = (wi >> 2) & 1, r_ = (wi & 3) + 4 * (wi >> 3);
                        __hip_atomic_fetch_or(hist + (q * 2 + h2) * IX_MROW + (j_ >> 1), 1u << (r_ + 16 * (j_ & 1)), __ATOMIC_RELAXED, __HIP_MEMORY_SCOPE_WORKGROUP); } } }
            __syncthreads();
            if ((unsigned)__builtin_amdgcn_readfirstlane((int)fail_l[0]) == 0u) { cand_done = true; break; }
            __syncthreads(); if (tid == 0) fail_l[0] = 0u; mode = IXM_FULL; sampled = false; continue; }
#pragma unroll 1
        for (int qq = 0; qq < 4; ++qq) { const int q = wid * 4 + qq, t = t0 + q, n = t + 1; int bs, ab, tot, bc;
            if (mode == IXM_FULL) {
                if (n <= 256) { if (lane == 0) { lof_l[q] = 0; fsh_l[q] = 10; } }
                else { ix_scan_row(hist + q * IX_HROW, 256, lane, bs, ab, tot, bc); if (lane == 0) { lof_l[q] = (bs + 1536) << 10; fsh_l[q] = 10; } } }
            else if (mode == IXM_SAMPLE) {
                int bhi, blo, d0, d1, d2; ix_scan_row(hist + q * IX_HROW, 1, lane, bs, ab, tot, bc);
                const float ks = 256.f * (float)tot / (float)n, mg = 4.f * sqrtf(ks) + 4.f;
                int rh = (int)(ks - mg); if (rh < 1) rh = 1; int rl = (int)(ks + mg) + 1; if (rl > tot) rl = tot;
                const bool bad = tot < 64;
                if (!bad) { ix_scan_row(hist + q * IX_HROW, rh, lane, bhi, d0, d1, d2); ix_scan_row(hist + q * IX_HROW, rl, lane, blo, d0, d1, d2); }
                else { bhi = 0; blo = 0; }
                if (lane == 0) { vlo_l[q] = ix_edge(blo); vhi_l[q] = ix_edge(bhi + 1); if (bad) fail_l[0] = 1u; } }
            else {
                if (n <= 256) { if (lane == 0) { pstar_l[q] = -1; need_l[q] = 0; } }
                else { const int need1 = 256 - (int)(hist[q * IX_HROW + 512] & 0xffffu); ix_scan_row(hist + q * IX_HROW, need1 > 0 ? need1 : 1, lane, bs, ab, tot, bc);
                    if (lane == 0) { pstar_l[q] = lof_l[q] + bs; need_l[q] = need1 - ab; } } } }
        __syncthreads();
        const unsigned failw = (unsigned)__builtin_amdgcn_readfirstlane((int)fail_l[0]);
        if (mode == IXM_FINE) mode = IXM_EMIT;
        else if (mode == IXM_FULL) mode = IXM_FINE;
        else { if (failw != 0u) { mode = IXM_FULL; sampled = false; __syncthreads(); if (tid == 0) fail_l[0] = 0u; } else mode = IXM_CAND; }
    }
#pragma unroll 1
    for (int qq = 0; qq < (cand_done ? 0 : 4); ++qq) { const int q = wid * 4 + qq; const int n0_ = (int)ccnt[q]; const int n = n0_ < IX_CAP ? n0_ : IX_CAP, need = need_l[q];
        const LAS unsigned* cd = (const LAS unsigned*)(L + IX_CAND) + q * IX_CAP * 2;
        if (lane < n) { const unsigned ms = cd[lane * 2], mk = cd[lane * 2 + 1]; int rank = 0;
            for (int i = 0; i < n; ++i) { const unsigned s = cd[i * 2], k = cd[i * 2 + 1]; rank += (s > ms || (s == ms && k < mk)) ? 1 : 0; }
            if (rank < need) { const int j = (int)(mk >> 5), wi = (int)(mk & 31u), h2 = (wi >> 2) & 1, r = (wi & 3) + 4 * (wi >> 3);
                __hip_atomic_fetch_or(hist + (q * 2 + h2) * IX_MROW + (j >> 1), 1u << (r + 16 * (j & 1)), __ATOMIC_RELAXED, __HIP_MEMORY_SCOPE_WORKGROUP); } } }
    __syncthreads();
    { unsigned* mw = (unsigned*)(ws + WS_MASK);
        for (int t64 = wid; t64 < ntile_e / 2; t64 += NWAVES)
            mw[((size_t)(b * (SEQ / 64) + t64) * SEQ + t0) * 2 + lane] = hist[lane * IX_MROW + t64]; }
    __syncthreads();
}

constexpr int RT_ROW = 132, RT_SC = 0, RT_TK = 128 * RT_ROW * 4  , RT_TKROW = 17, RT_PT = RT_TK + 128 * RT_TKROW * 4  , RT_END = RT_PT + 64;
#define CE_(a, b) do { const unsigned t_ = (a) > (b) ? (a) : (b); (b) = (a) > (b) ? (b) : (a); (a) = t_; } while (0)
__device__ __forceinline__ void sort16_desc(unsigned (&x)[16]) {
#pragma unroll
    for (int k = 2; k <= 16; k <<= 1)
#pragma unroll
        for (int j = k >> 1; j > 0; j >>= 1)
#pragma unroll
            for (int i = 0; i < 16; ++i) { const int l = i ^ j; if (l > i) { if ((i & k) == 0) CE_(x[i], x[l]); else CE_(x[l], x[i]); } }
}
__device__ __forceinline__ void merge16_desc(unsigned (&L)[16], const unsigned (&N)[16]) {
#pragma unroll
    for (int i = 0; i < 16; ++i) L[i] = L[i] > N[15 - i] ? L[i] : N[15 - i];
#pragma unroll
    for (int j = 8; j > 0; j >>= 1)
#pragma unroll
        for (int i = 0; i < 16; ++i) { const int l = i ^ j; if (l > i) CE_(L[i], L[l]); }
}
template <int CTRL> __device__ __forceinline__ void merge16_dpp(unsigned (&L)[16]) {
    unsigned N[16];
#pragma unroll
    for (int i = 0; i < 16; ++i) N[15 - i] = (unsigned)__builtin_amdgcn_mov_dpp((int)L[i], CTRL, 0xf, 0xf, true);
#pragma unroll
    for (int i = 0; i < 16; ++i) L[i] = L[i] > N[i] ? L[i] : N[i];
#pragma unroll
    for (int j = 8; j > 0; j >>= 1)
#pragma unroll
        for (int i = 0; i < 16; ++i) { const int l = i ^ j; if (l > i) CE_(L[i], L[l]); }
}
__device__ __forceinline__ float unsortable(unsigned k) { return __uint_as_float((k & 0x80000000u) ? (k ^ 0x80000000u) : ~k); }
struct RouteOps { bf16x8 bk[8]; bf16x8 aq[2][8]; };
__device__ __forceinline__ void route_load_bk(Frame& F, int h, RouteOps& R) {
    const int lane = F.lane, wid = F.wave, r32 = lane & 31, hi = lane >> 5, p = wid >> 2, nt = wid & 3;
    const bf16* sp = (const bf16*)(F.ws + WS_SUBK) + ((size_t)((h * 2 + p) * 128 + 32 * nt + r32)) * 128 + 8 * hi;
#pragma unroll
    for (int ks = 0; ks < 8; ++ks) R.bk[ks] = *(const bf16x8*)(sp + 16 * ks);
}
__device__ __forceinline__ void route_load_aq(Frame& F, int tt, int h, RouteOps& R) {
    const int lane = F.lane, wid = F.wave, r32 = lane & 31, hi = lane >> 5, p = wid >> 2;
#pragma unroll
    for (int mt = 0; mt < 2; ++mt) { const bf16* ap = (const bf16*)(F.ws + WS_QP) + (size_t)(tt * 64 + 32 * mt + r32) * DM + h * 256 + p * 128 + 8 * hi;
#pragma unroll
        for (int ks = 0; ks < 8; ++ks) R.aq[mt][ks] = *(const bf16x8*)(ap + 16 * ks); }
}
__device__ __forceinline__ void route_unit(Frame& F, int tt, int h, RouteOps& R, int ttn, int hn) {
    LAS unsigned char* L_ = F.lds; unsigned char* ws = F.ws;
    const int lane = F.lane, wid = F.wave, r32 = lane & 31, hi = lane >> 5; const int tok0 = tt * 64;
    LAS float* SC = (LAS float*)(L_ + RT_SC); LAS unsigned* TK = (LAS unsigned*)(L_ + RT_TK); const LAS unsigned char* PT = (const LAS unsigned char*)(L_ + RT_PT);
    { const int p = wid >> 2, nt = wid & 3;
#pragma unroll
        for (int mt = 0; mt < 2; ++mt) { f32x16 acc = {};
#pragma unroll
            for (int ks = 0; ks < 8; ++ks) acc = __builtin_amdgcn_mfma_f32_32x32x16_bf16(R.aq[mt][ks], R.bk[ks], acc, 0, 0, 0);
#pragma unroll
            for (int r = 0; r < 16; ++r) SC[(p * 64 + 32 * mt + crow(r, hi)) * RT_ROW + 32 * nt + r32] = acc[r]; }
        if (ttn >= 0) { if (hn != h) route_load_bk(F, hn, R); route_load_aq(F, ttn, hn, R); } }
    __syncthreads();
    { const int row = wid * 16 + (lane >> 2), part = lane & 3; unsigned Lk[16], Nk[16];
#pragma unroll
        for (int i = 0; i < 16; ++i) { const int n0 = part + 4 * i, n1 = part + 4 * (16 + i);
            Lk[i] = (sortable(SC[row * RT_ROW + n0]) & ~127u) | (unsigned)(127 - n0); Nk[i] = (sortable(SC[row * RT_ROW + n1]) & ~127u) | (unsigned)(127 - n1); }
        sort16_desc(Lk); sort16_desc(Nk); merge16_desc(Lk, Nk);
        merge16_dpp<0xB1>(Lk); merge16_dpp<0x4E>(Lk);
        if (part == 0) {
#pragma unroll
            for (int i = 0; i < 16; ++i) TK[row * RT_TKROW + i] = Lk[i]; } }
    __syncthreads();
    if (wid < 4) { const int tok = wid * 16 + (lane >> 2), part = lane & 3; unsigned Lk[16];
#pragma unroll
        for (int s = 0; s < 16; ++s) { const int q = 4 * s + part; const int pc = PT[q < 50 ? q : 0]; const int i = pc >> 4, j = pc & 15;
            const float sum = unsortable(TK[tok * RT_TKROW + i] & ~127u) + unsortable(TK[(64 + tok) * RT_TKROW + j] & ~127u);
            Lk[s] = q < 50 ? ((sortable(sum) & ~255u) | (unsigned)(((15 - i) << 4) | (15 - j))) : 0u; }
        sort16_desc(Lk); merge16_dpp<0xB1>(Lk); merge16_dpp<0x4E>(Lk);
        if (part == 0) { const size_t gtok = (size_t)tok0 + tok; const f32x4* sp4 = (const f32x4*)((const float*)(ws + WS_X1SS) + gtok * 32); float ssq = 0.f;
#pragma unroll
            for (int i = 0; i < 8; ++i) { const f32x4 v = sp4[i]; ssq += (v.x + v.y) + (v.z + v.w); }
            const float rl2 = 1.4426950409f / sqrtf(ssq * (1.f / DM) + EPS);
            float ex[16]; int ei[16]; float sm = 0.f; const float mx = unsortable(Lk[0] & ~255u);
#pragma unroll
            for (int k = 0; k < 16; ++k) { const int i = 15 - (int)((Lk[k] >> 4) & 15u), j = 15 - (int)(Lk[k] & 15u);
                ei[k] = (127 - (int)(TK[tok * RT_TKROW + i] & 127u)) * 128 + (127 - (int)(TK[(64 + tok) * RT_TKROW + j] & 127u));
                ex[k] = __builtin_amdgcn_exp2f((unsortable(Lk[k] & ~255u) - mx) * rl2); sm += ex[k]; }
            const float inv = 1.f / sm; int* eo = (int*)(ws + WS_EIDX) + gtok * 128 + h * 16; float* go = (float*)(ws + WS_EGATE) + gtok * 128 + h * 16;
#pragma unroll
            for (int k = 0; k < 4; ++k) { v4u e4; e4.x = (unsigned)ei[4 * k]; e4.y = (unsigned)ei[4 * k + 1]; e4.z = (unsigned)ei[4 * k + 2]; e4.w = (unsigned)ei[4 * k + 3]; *(v4u*)(eo + 4 * k) = e4;
                f32x4 g4; g4.x = ex[4 * k] * inv; g4.y = ex[4 * k + 1] * inv; g4.z = ex[4 * k + 2] * inv; g4.w = ex[4 * k + 3] * inv; *(f32x4*)(go + 4 * k) = g4; } } }
}
__device__ __forceinline__ void route_init(Frame& F) {
    if (F.tid < 64) { int q = F.tid, i = 0; for (; i < 16; ++i) { const int c = 16 / (i + 1); if (q < c) break; q -= c; }
        ((LAS unsigned char*)(F.lds + RT_PT))[F.tid] = (unsigned char)(i < 16 ? ((i << 4) | q) : 0); }
    __syncthreads();
}

constexpr int P9_UNR = 32, P9_UNRA = 32;
#define P9_PIN16(a_, o_) asm volatile("" : "+v"(a_[o_ + 0]), "+v"(a_[o_ + 1]), "+v"(a_[o_ + 2]), "+v"(a_[o_ + 3]), "+v"(a_[o_ + 4]), "+v"(a_[o_ + 5]), "+v"(a_[o_ + 6]), "+v"(a_[o_ + 7]), "+v"(a_[o_ + 8]), "+v"(a_[o_ + 9]), "+v"(a_[o_ + 10]), "+v"(a_[o_ + 11]), "+v"(a_[o_ + 12]), "+v"(a_[o_ + 13]), "+v"(a_[o_ + 14]), "+v"(a_[o_ + 15]))
#define P9_CBAR() do { asm volatile("" ::: "memory"); __builtin_amdgcn_sched_barrier(0); asm volatile("" ::: "memory"); } while (0)
#define P9_ROWHALF(A, B0, W0, W1, C) do { unsigned t0_, t1_; float t2_, t3_, t4_, t5_; asm volatile( \
    "v_and_b32 %[t0], 0x0f0f0f0f, %[w0]\n\tv_lshrrev_b32 %[t1], 4, %[w0]\n\tv_and_b32 %[t1], 0x0f0f0f0f, %[t1]\n\t" \
    "v_cvt_f32_ubyte0 %[t2], %[t0]\n\tv_cvt_f32_ubyte1 %[t3], %[t0]\n\tv_cvt_f32_ubyte2 %[t4], %[t0]\n\tv_cvt_f32_ubyte3 %[t5], %[t0]\n\t" \
    "v_fmac_f32 %[a0], %[c], %[t2]\n\tv_fmac_f32 %[a2], %[c], %[t3]\n\tv_fmac_f32 %[a4], %[c], %[t4]\n\tv_fmac_f32 %[a6], %[c], %[t5]\n\t" \
    "v_cvt_f32_ubyte0 %[t2], %[t1]\n\tv_cvt_f32_ubyte1 %[t3], %[t1]\n\tv_cvt_f32_ubyte2 %[t4], %[t1]\n\tv_cvt_f32_ubyte3 %[t5], %[t1]\n\t" \
    "v_and_b32 %[t0], 0x0f0f0f0f, %[w1]\n\tv_lshrrev_b32 %[t1], 4, %[w1]\n\t" \
    "v_fmac_f32 %[a1], %[c], %[t2]\n\tv_fmac_f32 %[a3], %[c], %[t3]\n\tv_fmac_f32 %[a5], %[c], %[t4]\n\tv_fmac_f32 %[a7], %[c], %[t5]\n\t" \
    "v_and_b32 %[t1], 0x0f0f0f0f, %[t1]\n\t" \
    "v_cvt_f32_ubyte0 %[t2], %[t0]\n\tv_cvt_f32_ubyte1 %[t3], %[t0]\n\tv_cvt_f32_ubyte2 %[t4], %[t0]\n\tv_cvt_f32_ubyte3 %[t5], %[t0]\n\t" \
    "v_fmac_f32 %[a8], %[c], %[t2]\n\tv_fmac_f32 %[a10], %[c], %[t3]\n\tv_fmac_f32 %[a12], %[c], %[t4]\n\tv_fmac_f32 %[a14], %[c], %[t5]\n\t" \
    "v_cvt_f32_ubyte0 %[t2], %[t1]\n\tv_cvt_f32_ubyte1 %[t3], %[t1]\n\tv_cvt_f32_ubyte2 %[t4], %[t1]\n\tv_cvt_f32_ubyte3 %[t5], %[t1]\n\t" \
    "v_fmac_f32 %[a9], %[c], %[t2]\n\tv_fmac_f32 %[a11], %[c], %[t3]\n\tv_fmac_f32 %[a13], %[c], %[t4]\n\tv_fmac_f32 %[a15], %[c], %[t5]" \
    : [a0] "+v"(A[B0 + 0]), [a1] "+v"(A[B0 + 1]), [a2] "+v"(A[B0 + 2]), [a3] "+v"(A[B0 + 3]), [a4] "+v"(A[B0 + 4]), [a5] "+v"(A[B0 + 5]), [a6] "+v"(A[B0 + 6]), [a7] "+v"(A[B0 + 7]), \
      [a8] "+v"(A[B0 + 8]), [a9] "+v"(A[B0 + 9]), [a10] "+v"(A[B0 + 10]), [a11] "+v"(A[B0 + 11]), [a12] "+v"(A[B0 + 12]), [a13] "+v"(A[B0 + 13]), [a14] "+v"(A[B0 + 14]), [a15] "+v"(A[B0 + 15]), \
      [t0] "=&v"(t0_), [t1] "=&v"(t1_), [t2] "=&v"(t2_), [t3] "=&v"(t3_), [t4] "=&v"(t4_), [t5] "=&v"(t5_) : [w0] "v"(W0), [w1] "v"(W1), [c] "s"(C)); } while (0)
#define P9_Q4(A, B0, W0, W1, W2, W3, C4) do { unsigned p0_, p1_, p2_, p3_, t0_, t1_, t2_, t3_, x0_, x1_; asm volatile( \
    "v_perm_b32 %[p0], %[w1], %[w0], %[sa]\n\tv_perm_b32 %[p1], %[w1], %[w0], %[sb]\n\tv_perm_b32 %[p2], %[w3], %[w2], %[sa]\n\tv_perm_b32 %[p3], %[w3], %[w2], %[sb]\n\t" \
    "v_perm_b32 %[t0], %[p2], %[p0], %[sc]\n\tv_perm_b32 %[t1], %[p2], %[p0], %[sd]\n\tv_perm_b32 %[t2], %[p3], %[p1], %[sc]\n\tv_perm_b32 %[t3], %[p3], %[p1], %[sd]\n\t" \
    "v_and_b32 %[x0], 0x0f0f0f0f, %[t0]\n\tv_and_b32 %[x1], 0xf0f0f0f0, %[t0]\n\tv_dot4c_i32_i8_e32 %[a0], %[c], %[x0]\n\tv_dot4c_i32_i8_e32 %[a1], %[c], %[x1]\n\t" \
    "v_and_b32 %[x0], 0x0f0f0f0f, %[t1]\n\tv_and_b32 %[x1], 0xf0f0f0f0, %[t1]\n\tv_dot4c_i32_i8_e32 %[a2], %[c], %[x0]\n\tv_dot4c_i32_i8_e32 %[a3], %[c], %[x1]\n\t" \
    "v_and_b32 %[x0], 0x0f0f0f0f, %[t2]\n\tv_and_b32 %[x1], 0xf0f0f0f0, %[t2]\n\tv_dot4c_i32_i8_e32 %[a4], %[c], %[x0]\n\tv_dot4c_i32_i8_e32 %[a5], %[c], %[x1]\n\t" \
    "v_and_b32 %[x0], 0x0f0f0f0f, %[t3]\n\tv_and_b32 %[x1], 0xf0f0f0f0, %[t3]\n\tv_dot4c_i32_i8_e32 %[a6], %[c], %[x0]\n\tv_dot4c_i32_i8_e32 %[a7], %[c], %[x1]" \
    : [a0] "+v"(A[B0 + 0]), [a1] "+v"(A[B0 + 1]), [a2] "+v"(A[B0 + 2]), [a3] "+v"(A[B0 + 3]), [a4] "+v"(A[B0 + 4]), [a5] "+v"(A[B0 + 5]), [a6] "+v"(A[B0 + 6]), [a7] "+v"(A[B0 + 7]), \
      [p0] "=&v"(p0_), [p1] "=&v"(p1_), [p2] "=&v"(p2_), [p3] "=&v"(p3_), [t0] "=&v"(t0_), [t1] "=&v"(t1_), [t2] "=&v"(t2_), [t3] "=&v"(t3_), [x0] "=&v"(x0_), [x1] "=&v"(x1_) \
    : [w0] "v"(W0), [w1] "v"(W1), [w2] "v"(W2), [w3] "v"(W3), [c] "s"(C4), [sa] "s"(0x05010400u), [sb] "s"(0x07030602u), [sc] "s"(0x05040100u), [sd] "s"(0x07060302u)); } while (0)
__device__ __forceinline__ void peer_sort_tokens4(Frame& F, int tok, LAS v2u* list) {
    unsigned char* ws = F.ws; const int lane = F.lane;
    const float* SU = (const float*)(ws + WS_SU); const float* SV = (const float*)(ws + WS_SV);
    int e0[4], e1[4]; float g0[4], g1[4], su0[4], su1[4], sv0[4], sv1[4];
#pragma unroll
    for (int t = 0; t < 4; ++t) { const int* eip = (const int*)(ws + WS_EIDX) + (size_t)(tok + t) * 128; const float* egp = (const float*)(ws + WS_EGATE) + (size_t)(tok + t) * 128;
        e0[t] = eip[lane]; e1[t] = eip[64 + lane]; g0[t] = egp[lane]; g1[t] = egp[64 + lane]; }
#pragma unroll
    for (int t = 0; t < 4; ++t) { su0[t] = SU[e0[t]]; su1[t] = SU[e1[t]]; sv0[t] = SV[e0[t]]; sv1[t] = SV[e1[t]]; }
    const unsigned long long lt = (lane == 0) ? 0ull : (~0ull >> (64 - lane));
#pragma unroll
    for (int t = 0; t < 4; ++t) {
        const int s0 = e0[t] >> 10, s1 = e1[t] >> 10; int base = 0, p0 = 0, p1 = 0;
#pragma unroll
        for (int s = 0; s < 16; ++s) { const unsigned long long m0 = __ballot(s0 == s), m1 = __ballot(s1 == s); const int c0 = __builtin_popcountll(m0);
            if (s0 == s) p0 = base + __builtin_popcountll(m0 & lt);
            if (s1 == s) p1 = base + c0 + __builtin_popcountll(m1 & lt);
            base += c0 + __builtin_popcountll(m1); }
        v2u a; a.x = (unsigned)e0[t] | (f2bf(su0[t]) << 16); a.y = __float_as_uint(g0[t] * sv0[t]); list[t * 128 + p0] = a;
        v2u b; b.x = (unsigned)e1[t] | (f2bf(su1[t]) << 16); b.y = __float_as_uint(g1[t] * sv1[t]); list[t * 128 + p1] = b; }
}
#ifndef R9
#define R9 32
#endif
#ifndef TB9
#define TB9 4
#endif
#ifndef NSL9
#define NSL9 4
#endif
#ifndef TU9
#define TU9 4
#endif
#ifndef P9_XPACE
#define P9_XPACE 0
#endif
#ifndef P9_WGSYNC
#define P9_WGSYNC 2
#endif
#ifndef UB9
#define UB9 16
#endif
#ifndef P9_STAGGER
#define P9_STAGGER 0
#endif
constexpr int CW_PACE = 200000;
__device__ __forceinline__ void p9_xcc_pace(const XcdBarrier& b) {
    if (b.st == nullptr) return;
    __builtin_amdgcn_s_barrier();
    if (threadIdx.x == 0) { const unsigned nloc = b.st[0];
        if (nloc > 1u) { unsigned* p = b.bar - CW_BAR + CW_PACE + 64 * b.x; const unsigned old = xb_add(p, 1u); const unsigned target = (old / nloc + 1u) * nloc;
            XB_SPIN(xb_ld(p) < target, b.bar); } }
    __builtin_amdgcn_s_barrier();
}
template <int CTRL> __device__ __forceinline__ int p9_dpp(int x) { return __builtin_amdgcn_mov_dpp(x, CTRL, 0xf, 0xf, true); }
__device__ __forceinline__ int p9_reduce16(int (&d)[16], int lane) {
    int e[8], f[4], g[2];
#pragma unroll
    for (int j = 0; j < 8; ++j) { auto r = __builtin_amdgcn_permlane32_swap((unsigned)d[j], (unsigned)d[j + 8], false, false); e[j] = (int)(r[0] + r[1]); }
#pragma unroll
    for (int j = 0; j < 4; ++j) { auto r = __builtin_amdgcn_permlane16_swap((unsigned)e[j], (unsigned)e[j + 4], false, false); f[j] = (int)(r[0] + r[1]); }
    const bool b3 = (lane & 8) != 0, b2 = (lane & 4) != 0;
#pragma unroll
    for (int j = 0; j < 2; ++j) { const int keep = b3 ? f[j + 2] : f[j], send = b3 ? f[j] : f[j + 2]; g[j] = keep + p9_dpp<0x128>(send); }
    const int keep = b2 ? g[1] : g[0], send = b2 ? g[0] : g[1];
    int h = keep + p9_dpp<0x141>(send);
    h += p9_dpp<0x4E>(h); h += p9_dpp<0xB1>(h);
    return h;
}
__device__ __forceinline__ int p9_reduce8(int (&d)[8], int lane) {
    int e[4], f[2];
#pragma unroll
    for (int j = 0; j < 4; ++j) { auto r = __builtin_amdgcn_permlane32_swap((unsigned)d[j], (unsigned)d[j + 4], false, false); e[j] = (int)(r[0] + r[1]); }
#pragma unroll
    for (int j = 0; j < 2; ++j) { auto r = __builtin_amdgcn_permlane16_swap((unsigned)e[j], (unsigned)e[j + 2], false, false); f[j] = (int)(r[0] + r[1]); }
    const bool b3 = (lane & 8) != 0;
    const int keep = b3 ? f[1] : f[0], send = b3 ? f[0] : f[1];
    int h = keep + p9_dpp<0x128>(send);
    h += p9_dpp<0x141>(h); h += p9_dpp<0x4E>(h); h += p9_dpp<0xB1>(h);
    return h;
}
__device__ __forceinline__ void peer_sweep(Frame& F, const XcdBarrier& bar) {
    unsigned char* ws = F.ws; const int lane = F.lane;
    LAS v2u* lists = (LAS v2u*)(F.lds + RING_OFF) + F.wave * (16 * 128);
    const int tokb = (F.vcu * NWAVES + F.wave) * 16;
    const float* x1ss = (const float*)(ws + WS_X1SS);
    const __amdgpu_buffer_rsrc_t rsH = __builtin_amdgcn_make_buffer_rsrc((void*)(ws + WS_X1G), 0, 128 << 20, 0x00020000), rsU = __builtin_amdgcn_make_buffer_rsrc((void*)(ws + WS_PU), 0, 16 << 20, 0x00020000),
        rsV = __builtin_amdgcn_make_buffer_rsrc((void*)(ws + WS_PV), 0, 16 << 20, 0x00020000), rsO = __builtin_amdgcn_make_buffer_rsrc((void*)F.out, 0, 256 << 20, 0x00020000);
    const int vl16 = 16 * lane, vl64 = 64 * lane, vl128 = 128 * lane;
#pragma unroll 1
    for (int tk = 0; tk < 16; tk += 4) peer_sort_tokens4(F, tokb + tk, lists + tk * 128);
    LDS_WAIT(); __builtin_amdgcn_wave_barrier();
    if (F.wave >= 4) { for (int i = 0; i < P9_STAGGER; ++i) __builtin_amdgcn_s_sleep(127); }
#pragma unroll 1
    for (int half = 0; half < 16 / TU9; ++half) {
        int qa[TU9][4], qb[TU9][4]; float sa[TU9];
#pragma unroll
        for (int tk = 0; tk < TU9; ++tk) { const int tok = tokb + half * TU9 + tk;
            const float rstd = 1.f / sqrtf(wave_sum(lane < 32 ? x1ss[(size_t)tok * 32 + lane] : 0.f) * (1.f / DM) + EPS);
            v4u hb[4]; float hf[32]; float am = 0.f;
#pragma unroll
            for (int q = 0; q < 4; ++q) hb[q] = __builtin_amdgcn_raw_buffer_load_b128(rsH, vl64 + 16 * q, tok * 4096, 0);
            f32x4 gq[8]; { int zo; asm volatile("s_mov_b32 %0, 0" : "=s"(zo)); const float* gp = F.in[9] + 32 * lane + zo;
#pragma unroll
                for (int q = 0; q < 8; ++q) gq[q] = *(const f32x4*)(gp + 4 * q); }
#pragma unroll
            for (int q = 0; q < 4; ++q) { const unsigned wv[4] = {hb[q].x, hb[q].y, hb[q].z, hb[q].w};
#pragma unroll
                for (int w = 0; w < 4; ++w) { hf[8 * q + 2 * w] = bflo(wv[w]) * gq[2 * q + (w >> 1)][2 * (w & 1)]; hf[8 * q + 2 * w + 1] = bfhi(wv[w]) * gq[2 * q + (w >> 1)][2 * (w & 1) + 1]; am = fmaxf(am, fmaxf(__builtin_fabsf(hf[8 * q + 2 * w]), __builtin_fabsf(hf[8 * q + 2 * w + 1]))); } }
            am = wave_max(am); const float inv = am > 0.f ? 119.f / am : 0.f; sa[tk] = rstd * am * (1.f / 119.f);
#pragma unroll
            for (int w = 0; w < 4; ++w) { unsigned A = 0u, B = 0u;
#pragma unroll
                for (int i = 0; i < 8; ++i) { const int q = (int)__builtin_rintf(hf[8 * w + i] * inv); const int a = (q + 8) >> 4, b = q - (a << 4);
                    A |= ((unsigned)a & 15u) << (4 * i); B |= ((unsigned)b & 15u) << (4 * i); }
                qa[tk][w] = (int)A; qb[tk][w] = (int)B; }
            P9_CBAR(); }
#define U_LOAD(buf, en_, s_) do { const LAS v2u* lp_ = lists + (half * TU9 + ((s_) % TU9)) * 128 + ((s_) / TU9) * UB9; en_ = lp_[lane / (64 / UB9)]; \
            _Pragma("unroll") for (int u = 0; u < UB9; ++u) { const int e_ = __builtin_amdgcn_readlane((int)(en_.x & 0x3fffu), (64 / UB9) * u); buf[u] = __builtin_amdgcn_raw_buffer_load_b128(rsU, vl16, e_ * 1024, 0); } } while (0)
#define U_DOT(buf, en_, s_) do { int d[UB9]; \
            _Pragma("unroll") for (int u = 0; u < UB9; ++u) { int dd = 0; const int wv[4] = {(int)buf[u].x, (int)buf[u].y, (int)buf[u].z, (int)buf[u].w}; \
                _Pragma("unroll") for (int w = 0; w < 4; ++w) dd = __builtin_amdgcn_sdot8(wv[w], qa[(s_) % TU9][w], dd, false); \
                dd <<= 4; \
                _Pragma("unroll") for (int w = 0; w < 4; ++w) dd = __builtin_amdgcn_sdot8(wv[w], qb[(s_) % TU9][w], dd, false); \
                d[u] = dd; } \
            const int dsum = UB9 == 16 ? p9_reduce16((int (&)[16])d, lane) : p9_reduce8((int (&)[8])d, lane); \
            if ((lane & (64 / UB9 - 1)) == 0 && pxu == 1) { LAS v2u* lp_ = lists + (half * TU9 + ((s_) % TU9)) * 128 + ((s_) / TU9) * UB9; const float act = (float)dsum * (__uint_as_float(en_.x & 0xffff0000u) * sa[(s_) % TU9]); \
                v2u o; o.x = en_.x; o.y = __float_as_uint(__uint_as_float(en_.y) * gelu_t(act)); lp_[lane / (64 / UB9)] = o; } } while (0)
#if P9_XPACE >= 1
        p9_xcc_pace(bar);
#endif
#ifdef PROBE_XU
        int pxu_n; asm volatile("s_mov_b32 %0, 2" : "=s"(pxu_n));
#pragma unroll 1
        for (int pxu = 0; pxu < pxu_n; ++pxu)
#else
        const int pxu = 1;
#endif
        { v4u bA[UB9], bB[UB9]; v2u enA, enB; constexpr int NS = TU9 * 32 / UB9;
            U_LOAD(bA, enA, 0); P9_CBAR();
#pragma unroll 1
            for (int b = 0; b < 4; ++b) {
#ifdef P9_WGSYNC
                __builtin_amdgcn_s_barrier();
#endif
                const LAS v2u* lists0 = lists; lists += b * 32;
#pragma unroll
                for (int s = 0; s < NS; s += 2) {
#if defined(P9_WGSYNC) && P9_WGSYNC >= 3
                    if (s > 0) __builtin_amdgcn_s_barrier();
#elif defined(P9_WGSYNC) && P9_WGSYNC >= 2
                    if (s == NS / 2) __builtin_amdgcn_s_barrier();
#endif
                    U_LOAD(bB, enB, s + 1); P9_CBAR(); U_DOT(bA, enA, s); P9_CBAR();
                    if (s + 2 < NS) { U_LOAD(bA, enA, s + 2); } else if (b + 1 < 4) { lists += 32; U_LOAD(bA, enA, 0); lists -= 32; }
                    P9_CBAR(); U_DOT(bB, enB, s + 1); P9_CBAR(); }
                lists = (LAS v2u*)lists0; } }
#undef U_LOAD
#undef U_DOT
    }
    LDS_WAIT(); __builtin_amdgcn_wave_barrier();
#pragma unroll 1
    for (int grp = 0; grp < 16 / TB9; ++grp) {
        int acc[TB9][32]; float csc[TB9]; int cs8[TB9];
#pragma unroll
        for (int tk = 0; tk < TB9; ++tk) {
            LAS v2u* lp = lists + (grp * TB9 + tk) * 128; const v2u ea = lp[lane], eb = lp[64 + lane];
            const float c0 = __uint_as_float(ea.y), c1 = __uint_as_float(eb.y);
            const float am = wave_max(fmaxf(__builtin_fabsf(c0), __builtin_fabsf(c1))); const float inv = am > 0.f ? 127.f / am : 0.f; csc[tk] = am * (1.f / 127.f);
            const int q0 = (int)__builtin_rintf(c0 * inv), q1 = (int)__builtin_rintf(c1 * inv);
            cs8[tk] = (int)wave_sum((float)(q0 + q1));
            LAS unsigned* wq = (LAS unsigned*)lp; LAS unsigned char* wb = (LAS unsigned char*)lp;
            asm volatile("" ::: "memory");
            wq[lane] = ea.x & 0x3fffu; wq[64 + lane] = eb.x & 0x3fffu; wb[512 + lane] = (unsigned char)q0; wb[576 + lane] = (unsigned char)q1;
#pragma unroll
            for (int i = 0; i < 32; ++i) acc[tk][i] = 0; }
        LDS_WAIT(); __builtin_amdgcn_wave_barrier();
#if P9_XPACE >= 1
        p9_xcc_pace(bar);
#endif
        static_assert(TB9 == 2 || TB9 == 4, "v sweep: two or four tokens per pass");
        constexpr int NQ = TB9 * 8;
        const LAS unsigned* idp = (const LAS unsigned*)(lists + grp * TB9 * 128) + (lane >> 5) * 256 + (lane & 31);
        const LAS unsigned* cqp = (const LAS unsigned*)(lists + grp * TB9 * 128) + ((lane >> 3) & (TB9 - 1)) * 256 + 128 + (lane & 7);
#define V_TK(q_) (((q_) >> 2) % TB9)
#define V_H(q_) ((q_) / (TB9 * 4))
#define V_LD4(slot, idr, q_) do { _Pragma("unroll") for (int r = 0; r < 4; ++r) { const int e_ = __builtin_amdgcn_readlane((int)(idr[V_TK(q_) >> 1]), (V_TK(q_) & 1) * 32 + V_H(q_) * 16 + ((q_) & 3) * 4 + r); \
            sl[slot][r] = __builtin_amdgcn_raw_buffer_load_b128(rsV, vl16, e_ * 1024, 0); } } while (0)
#define V_AC4(slot, q_) do { const int c4 = __builtin_amdgcn_readlane((int)cqc, V_TK(q_) * 8 + V_H(q_) * 4 + ((q_) & 3)) & cmask; \
            P9_Q4(acc[V_TK(q_)], 0, sl[slot][0].x, sl[slot][1].x, sl[slot][2].x, sl[slot][3].x, c4); P9_Q4(acc[V_TK(q_)], 8, sl[slot][0].y, sl[slot][1].y, sl[slot][2].y, sl[slot][3].y, c4); \
            P9_Q4(acc[V_TK(q_)], 16, sl[slot][0].z, sl[slot][1].z, sl[slot][2].z, sl[slot][3].z, c4); P9_Q4(acc[V_TK(q_)], 24, sl[slot][0].w, sl[slot][1].w, sl[slot][2].w, sl[slot][3].w, c4); \
            asm volatile("s_nop 4"); } while (0)
#ifdef PROBE_XV
        int pxv_n; asm volatile("s_mov_b32 %0, 2" : "=s"(pxv_n));
#pragma unroll 1
        for (int pxv = 0; pxv < pxv_n; ++pxv)
#else
        const int pxv = 1;
#endif
        { v4u sl[NSL9][4]; const int cmask = pxv == 1 ? -1 : 0; unsigned idc[TB9 / 2], idn[TB9 / 2];
#pragma unroll
            for (int t = 0; t < TB9 / 2; ++t) idc[t] = idp[t * 512];
#pragma unroll
            for (int q = 0; q < NSL9; ++q) V_LD4(q, idc, q);
            P9_CBAR();
#pragma unroll 1
            for (int b = 0; b < 4; ++b) {
#if P9_WGSYNC >= 1
                __builtin_amdgcn_s_barrier();
#endif
                const unsigned cqc = cqp[b * 8];
#pragma unroll
                for (int t = 0; t < TB9 / 2; ++t) idn[t] = idp[t * 512 + (b + 1 < 4 ? b + 1 : 3) * 32];
#pragma unroll
                for (int q = 0; q < NQ; ++q) {
#if P9_WGSYNC >= 2
                    if (q == NQ / 2) __builtin_amdgcn_s_barrier();
#endif
                    V_AC4(q % NSL9, q); P9_CBAR();
                    if (q + NSL9 < NQ) { V_LD4(q % NSL9, idc, q + NSL9); } else if (b + 1 < 4) { V_LD4(q % NSL9, idn, q + NSL9 - NQ); }
                    P9_CBAR(); }
#pragma unroll
                for (int t = 0; t < TB9 / 2; ++t) idc[t] = idn[t]; } }
#undef V_LD4
#undef V_AC4
#undef V_TK
#undef V_H
#pragma unroll
        for (int tk = 0; tk < TB9; ++tk) { const int tok = tokb + grp * TB9 + tk; const int cz = 8 * cs8[tk]; const float se = csc[tk], so = csc[tk] * (1.f / 16.f);
            int zopq; asm volatile("s_mov_b32 %0, 0" : "=s"(zopq));
            const float* gf = F.in[14] + 32 * lane + zopq; float ss = 0.f; float fa[32]; v4u xb[4];
#pragma unroll
            for (int q = 0; q < 4; ++q) xb[q] = __builtin_amdgcn_raw_buffer_load_b128(rsH, vl64 + 16 * q, tok * 4096, 0);
#pragma unroll
            for (int q = 0; q < 8; ++q) { f32x4 a; { const v4u hq = xb[q >> 1]; const unsigned w0 = (q & 1) ? hq.z : hq.x, w1 = (q & 1) ? hq.w : hq.y; a.x = bflo(w0); a.y = bfhi(w0); a.z = bflo(w1); a.w = bfhi(w1); } const int ai = 4 * q;
                fa[ai] = __builtin_fmaf((float)(acc[tk][ai] - cz), se, a.x); fa[ai + 1] = __builtin_fmaf((float)acc[tk][ai + 1], so, a.y);
                fa[ai + 2] = __builtin_fmaf((float)(acc[tk][ai + 2] - cz), se, a.z); fa[ai + 3] = __builtin_fmaf((float)acc[tk][ai + 3], so, a.w);
                ss += (fa[ai] * fa[ai] + fa[ai + 1] * fa[ai + 1]) + (fa[ai + 2] * fa[ai + 2] + fa[ai + 3] * fa[ai + 3]); }
            const float rf = 1.f / sqrtf(wave_sum(ss) * (1.f / DM) + EPS);
#pragma unroll
            for (int q = 0; q < 8; ++q) { const f32x4 g4 = *(const f32x4*)(gf + 4 * q); const int ai = 4 * q;
                f32x4 o; o.x = fa[ai] * rf * g4.x; o.y = fa[ai + 1] * rf * g4.y; o.z = fa[ai + 2] * rf * g4.z; o.w = fa[ai + 3] * rf * g4.w;
                __builtin_amdgcn_raw_buffer_store_b128(__builtin_bit_cast(v4u, o), rsO, vl128 + 16 * q, tok * 8192, 0); }
            P9_CBAR(); }
    }
}
__device__ __forceinline__ void peer_token2(Frame& F, int tok, LAS float* cbuf) {
    unsigned char* ws = F.ws; const int lane = F.lane;
    const float* x1ss = (const float*)(ws + WS_X1SS);
    const float rstd = 1.f / sqrtf(wave_sum(lane < 32 ? x1ss[(size_t)tok * 32 + lane] : 0.f) * (1.f / DM) + EPS);
    const __amdgpu_buffer_rsrc_t rsH = __builtin_amdgcn_make_buffer_rsrc((void*)(ws + WS_X1G), 0, 128 << 20, 0x00020000), rsU = __builtin_amdgcn_make_buffer_rsrc((void*)(ws + WS_PU), 0, 16 << 20, 0x00020000),
        rsV = __builtin_amdgcn_make_buffer_rsrc((void*)(ws + WS_PV), 0, 16 << 20, 0x00020000), rsO = __builtin_amdgcn_make_buffer_rsrc((void*)F.out, 0, 256 << 20, 0x00020000);
    const int vl16 = 16 * lane, vl64 = 64 * lane, vl128 = 128 * lane;
    int qlo[4], qhi[4]; float sh;
    { v4u hb[4]; float hf[32]; float am = 0.f;
#pragma unroll
        for (int q = 0; q < 4; ++q) hb[q] = __builtin_amdgcn_raw_buffer_load_b128(rsH, vl64 + 16 * q, tok * 4096, 0);
        f32x4 gq[8];
#pragma unroll
        for (int q = 0; q < 8; ++q) gq[q] = *(const f32x4*)(F.in[9] + 32 * lane + 4 * q);
#pragma unroll
        for (int q = 0; q < 4; ++q) { const unsigned wv[4] = {hb[q].x, hb[q].y, hb[q].z, hb[q].w};
#pragma unroll
            for (int w = 0; w < 4; ++w) { hf[8 * q + 2 * w] = bflo(wv[w]) * gq[2 * q + (w >> 1)][2 * (w & 1)]; hf[8 * q + 2 * w + 1] = bfhi(wv[w]) * gq[2 * q + (w >> 1)][2 * (w & 1) + 1]; am = fmaxf(am, fmaxf(__builtin_fabsf(hf[8 * q + 2 * w]), __builtin_fabsf(hf[8 * q + 2 * w + 1]))); } }
        am = wave_max(am); const float inv = am > 0.f ? 127.f / am : 0.f; sh = am * (1.f / 127.f);
#pragma unroll
        for (int w = 0; w < 4; ++w) { qlo[w] = (int)pack_q8(hf[8 * w], hf[8 * w + 2], hf[8 * w + 4], hf[8 * w + 6], inv, 0); qhi[w] = (int)pack_q8(hf[8 * w + 1], hf[8 * w + 3], hf[8 * w + 5], hf[8 * w + 7], inv, 0); } }
    const float sa = rstd * sh * (1.f / 16.f);
    const int* eip = (const int*)(ws + WS_EIDX) + (size_t)tok * 128; const float* egp = (const float*)(ws + WS_EGATE) + (size_t)tok * 128;
    const int e0 = eip[lane], e1 = eip[64 + lane]; const float g0 = egp[lane], g1 = egp[64 + lane];
    const float* SU = (const float*)(ws + WS_SU); const float* SV = (const float*)(ws + WS_SV);
    const float su0 = SU[e0], su1 = SU[e1], sv0 = SV[e0], sv1 = SV[e1];
#define T2_LOAD(buf, rs, kk_) do { _Pragma("unroll") for (int u = 0; u < 16; ++u) { const int e_ = __builtin_amdgcn_readlane((kk_) < 64 ? e0 : e1, ((kk_) + u) & 63); buf[u] = __builtin_amdgcn_raw_buffer_load_b128(rs, vl16, e_ * 1024, 0); } } while (0)
#define T2_DOT(buf, kk_) do { int d[16]; _Pragma("unroll") for (int u = 0; u < 16; ++u) { int dd = 0; const unsigned wv[4] = {buf[u].x, buf[u].y, buf[u].z, buf[u].w}; \
        _Pragma("unroll") for (int w = 0; w < 4; ++w) { dd = __builtin_amdgcn_sdot4((int)((wv[w] << 4) & 0xf0f0f0f0u), qlo[w], dd, false); dd = __builtin_amdgcn_sdot4((int)(wv[w] & 0xf0f0f0f0u), qhi[w], dd, false); } d[u] = dd; } \
        _Pragma("unroll") for (int o = 1; o < 64; o <<= 1) { _Pragma("unroll") for (int u = 0; u < 16; ++u) d[u] += __shfl_xor(d[u], o); } \
        const int myu = (lane - (kk_)) & 63; int dsel = 0; _Pragma("unroll") for (int u = 0; u < 16; ++u) dsel = (myu == u) ? d[u] : dsel; \
        if (myu < 16) { const float act = (float)dsel * (((kk_) < 64 ? su0 : su1) * sa); cbuf[(kk_) + myu] = ((kk_) < 64 ? g0 : g1) * gelu_t(act) * ((kk_) < 64 ? sv0 : sv1); } } while (0)
#define T2_ACC(buf, kk_) do { _Pragma("unroll") for (int u = 0; u < 16; ++u) { const float c = __uint_as_float(__builtin_amdgcn_readfirstlane((int)__float_as_uint(cbuf[(kk_) + u]))); csum += c; \
        P9_ROWHALF(acc, 0, buf[u].x ^ 0x80808080u, buf[u].y ^ 0x80808080u, c); P9_ROWHALF(acc, 16, buf[u].z ^ 0x80808080u, buf[u].w ^ 0x80808080u, c); } } while (0)
    { v4u bA[16], bB[16];
        T2_LOAD(bA, rsU, 0); P9_CBAR();
#pragma unroll 1
        for (int kk = 0; kk < 128; kk += 32) {
            T2_LOAD(bB, rsU, kk + 16); P9_CBAR(); T2_DOT(bA, kk); P9_CBAR();
            if (kk + 32 < 128) { T2_LOAD(bA, rsU, kk + 32); } P9_CBAR(); T2_DOT(bB, kk + 16); P9_CBAR(); } }
    LDS_WAIT(); __builtin_amdgcn_wave_barrier();
    float acc[32]; float csum = 0.f;
#pragma unroll
    for (int i = 0; i < 32; ++i) acc[i] = 0.f;
    { v4u bA[16], bB[16];
        T2_LOAD(bA, rsV, 0); P9_CBAR();
#pragma unroll 1
        for (int kk = 0; kk < 128; kk += 32) {
            T2_LOAD(bB, rsV, kk + 16); P9_CBAR(); T2_ACC(bA, kk); P9_CBAR();
            if (kk + 32 < 128) { T2_LOAD(bA, rsV, kk + 32); } P9_CBAR(); T2_ACC(bB, kk + 16); P9_CBAR(); } }
#undef T2_LOAD
#undef T2_DOT
#undef T2_ACC
    LDS_WAIT(); __builtin_amdgcn_wave_barrier();
    const float cz = -8.f * csum;
    int zopq; asm volatile("s_mov_b32 %0, 0" : "=s"(zopq));
    const float* gf = F.in[14] + 32 * lane + zopq; float ss = 0.f; v4u xb[4];
#pragma unroll
    for (int q = 0; q < 4; ++q) xb[q] = __builtin_amdgcn_raw_buffer_load_b128(rsH, vl64 + 16 * q, tok * 4096, 0);
#pragma unroll
    for (int q = 0; q < 8; ++q) { f32x4 a; { const v4u hq = xb[q >> 1]; const unsigned w0 = (q & 1) ? hq.z : hq.x, w1 = (q & 1) ? hq.w : hq.y; a.x = bflo(w0); a.y = bfhi(w0); a.z = bflo(w1); a.w = bfhi(w1); } const int ai = 4 * q;
        acc[ai] += a.x + cz; acc[ai + 1] += a.y + cz; acc[ai + 2] += a.z + cz; acc[ai + 3] += a.w + cz; ss += (acc[ai] * acc[ai] + acc[ai + 1] * acc[ai + 1]) + (acc[ai + 2] * acc[ai + 2] + acc[ai + 3] * acc[ai + 3]); }
    const float rf = 1.f / sqrtf(wave_sum(ss) * (1.f / DM) + EPS);
#pragma unroll
    for (int q = 0; q < 8; ++q) { const f32x4 gg = *(const f32x4*)(gf + 4 * q); const int ai = 4 * q;
        f32x4 o; o.x = acc[ai] * rf * gg.x; o.y = acc[ai + 1] * rf * gg.y; o.z = acc[ai + 2] * rf * gg.z; o.w = acc[ai + 3] * rf * gg.w;
        __builtin_amdgcn_raw_buffer_store_b128(__builtin_bit_cast(v4u, o), rsO, vl128 + 16 * q, tok * 8192, 0); }
}
#undef P9_PIN16
#undef P9_CBAR
#undef P9_ROWHALF
#undef P9_Q4

#ifndef G4_ALIGN
#define G4_ALIGN true
#endif
#ifndef G4_SP2
#define G4_SP2 true
#endif
__device__ __forceinline__ void phase0(Frame& F, unsigned char* lds) {
    unsigned char* ws = F.ws;
 p0_prologue(F);
}
__device__ __forceinline__ void phase1(Frame& F, unsigned char* lds, const XcdBarrier& bar) {
    unsigned char* ws = F.ws;
    quant_win_rows(F); xcd_barrier(bar);
    { pg8::Gemm g{(const pg8::bf16_t*)(ws + WS_XN8), (const pg8::bf16_t*)(ws + WS_WIN8), MT, NI8, DM / 2}; pg8::StaticOrder S; S.init(MT, NI8, F.G, (int)blockIdx.x);
      pg8::EpiInProj<true> E{ws, 0};
      pg8::gemm_phase<pg8::EpiInProj<true>, pg8::StaticOrder, true, true, true>(F.lds + RING_OFF, g, S, E); }
    { pg8::Gemm g{(const pg8::bf16_t*)(ws + WS_XN), (const pg8::bf16_t*)(ws + WS_WIN) + (size_t)NI8 * DM, MT, NINP - NI8, DM}; pg8::StaticOrder S; S.init(MT, NINP - NI8, F.G, (int)blockIdx.x);
      pg8::EpiInProj<false> E{ws, NI8 / 256};
      pg8::gemm_phase<pg8::EpiInProj<false>, pg8::StaticOrder, true, true, false>(F.lds + RING_OFF, g, S, E); }
}
__device__ __forceinline__ void phase2(Frame& F, unsigned char* lds) {
    unsigned char* ws = F.ws;
#ifndef REPEAT_MASK
#define REPEAT_MASK 0
#endif
#pragma unroll 1
        for (int rep_ = 0; rep_ < 1 + ((REPEAT_MASK >> 10) & 1); ++rep_)
        for (int i = F.vcu; i < 1024; i += F.G) { const int b = i >> 9, x = i & 511; const int qb = (x >> 8) ? 511 - (x & 255) : (x & 255); idx_unit(F, b, qb); }
#pragma unroll 1
        for (int rep_ = 0; rep_ < 1 + ((REPEAT_MASK >> 11) & 1); ++rep_)
        for (int i = F.vcu; i < 2048; i += F.G) gmlp_unit(F, i >> 3, i & 7);

}
__device__ __forceinline__ void phase3(Frame& F, unsigned char* lds) {
    unsigned char* ws = F.ws;
        const int total = BATCH * AH * 32;
        int Lc = F.vcu;
        if (Lc < total) {
            att::Bufs AB;
            AB.q = __builtin_amdgcn_make_buffer_rsrc((void*)(ws + WS_Q), 0, 64 << 20, 0x00020000); AB.k = __builtin_amdgcn_make_buffer_rsrc((void*)(ws + WS_K), 0, 64 << 20, 0x00020000);
            AB.v = __builtin_amdgcn_make_buffer_rsrc((void*)(ws + WS_V), 0, 64 << 20, 0x00020000); AB.o = __builtin_amdgcn_make_buffer_rsrc((void*)(ws + WS_YA), 0, 64 << 20, 0x00020000);
            AB.m = __builtin_amdgcn_make_buffer_rsrc((void*)(ws + WS_MASK), 0, 64 << 20, 0x00020000);
#define ATT_REF(R, L_, pass_) do { const unsigned bh_ = (unsigned)(L_) >> 5, x_ = (unsigned)(L_) & 31u, qb_ = (pass_) ? 63u - x_ : x_, b_ = bh_ >> 3, h_ = bh_ & 7u; \
            (R).qo = (bh_ * SEQ + qb_ * 256u) * 256u; (R).ko = bh_ * (SEQ * 256u); (R).vo = (R).ko; \
            (R).oo = ((b_ * SEQ + qb_ * 256u) * AW + h_ * 128u) * 2u; (R).mo = b_ * ((SEQ / 64) * SEQ * 8u); (R).P0 = (int)(qb_ * 256u); } while (0)
            att::BlockRef cur, nxt; int pass = 0; ATT_REF(cur, Lc, 0);
            att::Seam S;
            att::attn_prime(AB, cur, (char*)lds + RING_OFF, S);
            for (;;) {
                const bool more_pass = pass == 0, more_item = Lc + F.G < total, last = !more_pass && !more_item;
                int passn = pass + 1, Ln = Lc;
                if (!more_pass) { passn = 0; Ln = more_item ? Lc + F.G : Lc; }
                if (last) nxt = cur; else ATT_REF(nxt, Ln, passn);
                att::attn_block(AB, cur, nxt, SEQ, (char*)lds + RING_OFF, S);
                if (last) break;
                cur = nxt; pass = passn; Lc = Ln;
            }
#undef ATT_REF
        }

}
__device__ __forceinline__ void phase4(Frame& F, unsigned char* lds) {
    unsigned char* ws = F.ws;
        pg8::Gemm g{(const pg8::bf16_t*)(ws + WS_YA), (const pg8::bf16_t*)(ws + WS_WA), MT, DM, AW}; pg8::StaticOrder S; S.init(MT, DM, F.G, (int)blockIdx.x);
        pg8::EpiMix<false> E{(const unsigned char*)(ws + WS_GA), (pg8::bf16_t*)(ws + WS_MIXED)};
        pg8::gemm_phase<pg8::EpiMix<false>, pg8::StaticOrder, G4_ALIGN, G4_SP2>(F.lds + RING_OFF, g, S, E);

}
__device__ __forceinline__ void phase5(Frame& F, unsigned char* lds) {
    unsigned char* ws = F.ws;
        pg8::Gemm g{(const pg8::bf16_t*)(ws + WS_YB), (const pg8::bf16_t*)(ws + WS_WB), MT, DM, GW}; pg8::StaticOrder S; S.init(MT, DM, F.G, (int)blockIdx.x);
        pg8::EpiMix<true> E{(const unsigned char*)(ws + WS_GB), (pg8::bf16_t*)(ws + WS_MIXED)};
        pg8::gemm_phase<pg8::EpiMix<true>, pg8::StaticOrder, G4_ALIGN, G4_SP2>(F.lds + RING_OFF, g, S, E);

}
__device__ __forceinline__ void phase6(Frame& F, unsigned char* lds) {
    unsigned char* ws = F.ws;
        pg8::Gemm g{(const pg8::bf16_t*)(ws + WS_MIXED), (const pg8::bf16_t*)(ws + WS_WO), MT, DM, DM}; pg8::StaticOrder S; S.init(MT, DM, F.G, (int)blockIdx.x);
        pg8::EpiWo E{F.in[0], (pg8::bf16_t*)(ws + WS_X1G), (float*)(ws + WS_X1SS)};
        pg8::gemm_phase<pg8::EpiWo, pg8::StaticOrder, G4_ALIGN, G4_SP2>(F.lds + RING_OFF, g, S, E);

}
__device__ __forceinline__ void phase7(Frame& F, unsigned char* lds) {
    unsigned char* ws = F.ws;
        pg8::Gemm g{(const pg8::bf16_t*)(ws + WS_X1G), (const pg8::bf16_t*)(ws + WS_WQ), MT, DM, DM}; pg8::StaticOrder S; S.init(MT, DM, F.G, (int)blockIdx.x);
        pg8::EpiPlainBf16 E{(pg8::bf16_t*)(ws + WS_QP), DM};
        pg8::gemm_phase<pg8::EpiPlainBf16, pg8::StaticOrder, G4_ALIGN, G4_SP2>(F.lds + RING_OFF, g, S, E);

}
__device__ __forceinline__ void phase8(Frame& F, unsigned char* lds) {
    unsigned char* ws = F.ws;

        route_init(F);
        { const int NU = (MT / 64) * 8; RouteOps R;
            if (F.vcu < NU) { route_load_bk(F, F.vcu & 7, R); route_load_aq(F, F.vcu >> 3, F.vcu & 7, R); }
#pragma unroll 1
            for (int i = F.vcu; i < NU; i += F.G) { const int in = i + F.G; route_unit(F, i >> 3, i & 7, R, in < NU ? in >> 3 : -1, in & 7); } }
        __syncthreads();

}
__device__ __forceinline__ void phase9(Frame& F, unsigned char* lds, const XcdBarrier& bar) {
    if (F.G * NWAVES * 16 == MT) { peer_sweep(F, bar); return; }
    LAS float* cbuf = (LAS float*)(F.lds + RING_OFF) + F.wave * 128;
    const int gw = F.vcu * NWAVES + F.wave, NGW = F.G * NWAVES;
    for (int tok = gw; tok < MT; tok += NGW) peer_token2(F, tok, cbuf);
}
struct Args { const float* in[15]; float* out; unsigned char* ws; int ph_lo, ph_hi, li, pad; };
__global__ void __launch_bounds__(NWAVES * 64, 2) fwd_kernel(Args args) {
    extern __shared__ __attribute__((aligned(16))) unsigned char lds[];
    Frame F;
    F.lds = (LAS unsigned char*)lds;
    F.MISC = (volatile LAS unsigned*)(F.lds + MISC_OFF);
    F.tid = threadIdx.x; F.lane = F.tid & 63; F.wave = __builtin_amdgcn_readfirstlane(F.tid >> 6);
    F.G = gridDim.x; { const int bx = blockIdx.x; F.vcu = (F.G % 8 == 0) ? (bx % 8) * (F.G / 8) + bx / 8 : bx; }
    F.ws = args.ws; F.ctl = (gu32*)(args.ws + WS_CTL); F.out = args.out;
#pragma unroll
    for (int i = 0; i < 15; ++i) F.in[i] = args.in[i];
    for (int u = F.tid; u < (LDS_BYTES - LDSCTL_OFF) / 4; u += NWAVES * 64) ((LAS unsigned*)(F.lds + LDSCTL_OFF))[u] = 0u;
    __syncthreads();
    const int bli = (N_LAUNCHES == PER_PHASE) ? 0 : args.li;
    XcdBarrier bar; bar.bar = (unsigned*)(F.ctl + CW_BAR) + bli * XCD_BAR_WORDS; bar.x = 0; bar.st = nullptr;
    if (N_LAUNCHES != PER_PHASE) bar = xcd_barrier_post((unsigned*)(F.ctl + CW_BAR) + bli * XCD_BAR_WORDS, F.MISC + 8);
#define GRID_BAR(seam) do { if (N_LAUNCHES == PER_PHASE) { if (F.tid == 0) __hip_atomic_store(F.ctl + CW_TMO, 0xBADBA0u | (unsigned)(seam), RLX_AGENT); } else { xcd_barrier(bar); } } while (0)
    const int lo = args.ph_lo, hi = args.ph_hi;
#ifndef PHASE_MASK
#define PHASE_MASK 0x3ff
#endif
#define IN(k) (((PHASE_MASK >> (k)) & 1) && lo <= (k) && (k) < hi)
#define BOTH(k) (IN(k) && IN((k) + 1))
    unsigned char* ws = args.ws;

#define REP(k) ((REPEAT_MASK >> (k)) & 1)
#define RUNPH(k, call) do { if (IN(k)) { call; if (REP(k)) { GRID_BAR(k); call; } if (BOTH(k)) GRID_BAR(k); } } while (0)
    RUNPH(0, phase0(F, lds));
    RUNPH(1, phase1(F, lds, bar));
    RUNPH(2, phase2(F, lds));
    RUNPH(3, phase3(F, lds));
    do { if (IN(4)) { phase4(F, lds); if (REP(4)) { GRID_BAR(4); phase4(F, lds); } if (BOTH(4)) { asm volatile("s_waitcnt vmcnt(0)" ::: "memory"); __syncthreads(); } } } while (0);
    RUNPH(5, phase5(F, lds));
    RUNPH(6, phase6(F, lds));
    RUNPH(7, phase7(F, lds));
    RUNPH(8, phase8(F, lds));
    RUNPH(9, phase9(F, lds, bar));
#undef RUNPH
#undef IN
#undef BOTH
}

extern "C" void kernel_launch(void* const* d_in, const int* in_sizes, int n_in, void* d_out, int out_size, void* d_ws, size_t ws_size, hipStream_t stream) {
    static int grid = 0;
    if (grid == 0) {
        if (n_in != 15 || in_sizes[0] != MT * DM || out_size != MT * DM || ws_size < WS_END) {
            fprintf(stderr, "kernel_launch: built for 15 inputs, x/out of %d floats, >= %zu bytes of workspace; got n_in %d, in0 %d, out %d, ws %zu; nothing launched\n", MT * DM, (size_t)WS_END, n_in, n_in > 0 ? in_sizes[0] : -1, out_size, ws_size); grid = -1; return; }
        int dev = 0, cus = 0, per_cu = 0;
        if (hipGetDevice(&dev) != hipSuccess || hipDeviceGetAttribute(&cus, hipDeviceAttributeMultiprocessorCount, dev) != hipSuccess) { fprintf(stderr, "kernel_launch: device query failed\n"); grid = -1; return; }
        if (hipFuncSetAttribute((const void*)fwd_kernel, hipFuncAttributeMaxDynamicSharedMemorySize, LDS_BYTES) != hipSuccess) { fprintf(stderr, "kernel_launch: hipFuncSetAttribute failed\n"); grid = -1; return; }
        if (hipOccupancyMaxActiveBlocksPerMultiprocessor(&per_cu, (const void*)fwd_kernel, NWAVES * 64, LDS_BYTES) != hipSuccess || per_cu < 1)
            fprintf(stderr, "kernel_launch: note: occupancy query reports %d workgroups per CU\n", per_cu);
        (void)hipGetLastError();
        grid = cus;
    }
    if (grid < 0) return;
    if (hipMemsetAsync((char*)d_ws + WS_CTL, 0, CTL_ZERO_BYTES, stream) != hipSuccess) { fprintf(stderr, "kernel_launch: memset failed\n"); return; }
    Args a{};
    for (int i = 0; i < 15; ++i) a.in[i] = (const float*)d_in[i];
    a.out = (float*)d_out; a.ws = (unsigned char*)d_ws; a.pad = 0;
    for (int li = 0; li < N_LAUNCHES; ++li) {
        a.ph_lo = (N_LAUNCHES == PER_PHASE) ? li : 0; a.ph_hi = (N_LAUNCHES == PER_PHASE) ? li + 1 : PER_PHASE; a.li = li;
        hipLaunchKernelGGL(fwd_kernel, dim3(grid), dim3(NWAVES * 64), LDS_BYTES, stream, a);
        const hipError_t le = hipPeekAtLastError();
        if (le != hipSuccess) { fprintf(stderr, "kernel_launch: launch %d failed: %s\n", li, hipGetErrorName(le)); break; }
    }
}
```
